# Optimizing an MI355X kernel written in HIP

```python
import math
import jax
import jax.numpy as jnp
from jax import lax
import numpy as np

D_MODEL = 2048
BATCH = 1
SEQ = 16384
DEPTH = 4

GRID_W = 64
CTX_LEN = 256
N_MIXERS = 3
N_HYENA_LAYERS = (DEPTH + 2) // 3
N_ATTN_LAYERS = (DEPTH + 1) // 3
N_POOL_LAYERS = DEPTH // 3
N_MOD = 9
NORM_EPS = 1e-6
D_FF = 5632
FFN_RES = 0.5
FILTER_BANDS = 16
FILTER_EMB = 1 + 2 * FILTER_BANDS
FILTER_HIDDEN = 64
DECAY_TARGET = 1e-2
SHORT_DECAY_PCT = 0.3
LONG_DECAY_PCT = 1.5
HEAD_DIM = 128
N_HEADS = D_MODEL // HEAD_DIM
N_KV_HEADS = 4
GROUP = N_HEADS // N_KV_HEADS
WINDOW = 128
ATTN_BLOCK = 128
ROPE_THETA = 10000.0
ROPE_PAIRS = HEAD_DIM // 4
QKV_DIM = (N_HEADS + 2 * N_KV_HEADS) * HEAD_DIM
POOL_SIZES = (2, 4, 8, 16)
POOL_GROUP = D_MODEL // len(POOL_SIZES)

kernel_name = 'hybrid_hyena_swa_pool_diffusion_trunk'


def rms_norm(x, g):
    xf = x.astype(jnp.float32)
    y = xf * lax.rsqrt(jnp.mean(xf * xf, axis=-1, keepdims=True) + NORM_EPS)
    return (y * g.astype(jnp.float32)).astype(x.dtype)


def modulate(h, g, mod, k):
    return rms_norm(h, g) * (1.0 + mod[:, 3 * k + 1]) + mod[:, 3 * k]


def gated_residual(h, y, g, mod, k, weight):
    return h + weight * mod[:, 3 * k + 2] * rms_norm(y, g)


def swiglu(u, w_in, w_out):
    gate, up = jnp.split(u @ w_in, 2, axis=-1)
    return (jax.nn.silu(gate) * up) @ w_out


def short_conv3(u, w, b):
    up = jnp.pad(u, ((0, 0), (1, 1), (0, 0)))
    return up[:, :-2] * w[0] + u * w[1] + up[:, 2:] * w[2] + b


def implicit_filter(L, w1, b1, w2, b2, w3, b3, w4, freq):
    D = w4.shape[1] // 2
    t = jnp.linspace(0.0, 1.0, L, dtype=jnp.float32)[:, None]
    omega = 2.0 * math.pi * jnp.arange(L, dtype=jnp.float32)[:, None] / L
    bands = jnp.linspace(1e-4, FILTER_BANDS - 1, FILTER_BANDS, dtype=jnp.float32)[None, :]
    z = jnp.concatenate([t, jnp.cos(bands * omega), -jnp.sin(bands * omega)], axis=-1)
    f = jnp.sin(freq[0] * (z @ w1 + b1))
    f = jnp.sin(freq[1] * (f @ w2 + b2))
    f = jnp.sin(freq[2] * (f @ w3 + b3))
    f = (f @ w4).astype(jnp.float32)
    deltas = jnp.abs(jnp.linspace(math.log(DECAY_TARGET) / LONG_DECAY_PCT,
                                  math.log(DECAY_TARGET) / SHORT_DECAY_PCT, D, dtype=jnp.float32))
    decay = jnp.exp(-t * deltas[None, :])
    h_fwd = f[:, :D] * decay
    h_bwd = f[:, D:] * decay
    return jnp.concatenate([h_fwd, jnp.zeros((1, D), jnp.float32), h_bwd[1:][::-1]], axis=0)


def long_conv(u, filt, skip):
    L = u.shape[1]
    uf = jnp.fft.rfft(u.astype(jnp.float32), n=2 * L, axis=1)
    ff = jnp.fft.rfft(filt, n=2 * L, axis=0)
    y = jnp.fft.irfft(uf * ff[None], n=2 * L, axis=1)[:, :L]
    return (y + u.astype(jnp.float32) * skip.astype(jnp.float32)).astype(u.dtype)


def hyena_mixer(u, w_in, b_in, w_sc, b_sc, f_w1, f_b1, f_w2, f_b2, f_w3, f_b3, f_w4, f_freq, skip, w_out, b_out):
    L = u.shape[1]
    z = short_conv3(u @ w_in + b_in, w_sc, b_sc)
    x0, x1, v = jnp.split(z, 3, axis=-1)
    filt = implicit_filter(L, f_w1, f_b1, f_w2, f_b2, f_w3, f_b3, f_w4, f_freq)
    y = x0 * long_conv(v * x1, filt, skip)
    return y @ w_out + b_out


def axial_rope(x, ang_row, ang_col):
    extra = x.ndim - 3

    def rot(v, ang):
        ang = ang.reshape((ang.shape[0],) + (1,) * extra + (ang.shape[1],))
        cos, sin = jnp.cos(ang).astype(v.dtype), jnp.sin(ang).astype(v.dtype)
        v1, v2 = jnp.split(v, 2, axis=-1)
        return jnp.concatenate([v1 * cos - v2 * sin, v2 * cos + v1 * sin], axis=-1)

    xr, xc = jnp.split(x, 2, axis=-1)
    return jnp.concatenate([rot(xr, ang_row), rot(xc, ang_col)], axis=-1)


def windowed_gqa(u, uc, w_qkv, b_qkv, sink, w_o, b_o, ang_row, ang_col, ctx_queries):
    B, L, D = u.shape
    C = uc.shape[1]
    nb = L // ATTN_BLOCK
    scale = HEAD_DIM ** -0.5
    qd, kd = N_HEADS * HEAD_DIM, N_KV_HEADS * HEAD_DIM
    qkv = u @ w_qkv + b_qkv
    q = qkv[..., :qd].reshape(B, L, N_KV_HEADS, GROUP, HEAD_DIM)
    k = qkv[..., qd:qd + kd].reshape(B, L, N_KV_HEADS, HEAD_DIM)
    v = qkv[..., qd + kd:].reshape(B, L, N_KV_HEADS, HEAD_DIM)
    q = axial_rope(q, ang_row, ang_col)
    k = axial_rope(k, ang_row, ang_col)
    qkv_c = uc @ w_qkv + b_qkv
    kc = qkv_c[..., qd:qd + kd].reshape(B, C, N_KV_HEADS, HEAD_DIM)
    vc = qkv_c[..., qd + kd:].reshape(B, C, N_KV_HEADS, HEAD_DIM)
    sink_l = sink.astype(jnp.float32).reshape(N_KV_HEADS, GROUP)[None, :, :, None, None, None]

    qb = q.reshape(B, nb, ATTN_BLOCK, N_KV_HEADS, GROUP, HEAD_DIM)

    def neighbours(t):
        tp = jnp.pad(t, ((0, 0), (ATTN_BLOCK, ATTN_BLOCK), (0, 0), (0, 0)))
        tp = tp.reshape(B, nb + 2, ATTN_BLOCK, N_KV_HEADS, HEAD_DIM)
        return jnp.concatenate([tp[:, :-2], tp[:, 1:-1], tp[:, 2:]], axis=2)

    kb, vb = neighbours(k), neighbours(v)
    qi = jnp.arange(ATTN_BLOCK)[:, None]
    si = jnp.arange(3 * ATTN_BLOCK)[None, :]
    rel = si - ATTN_BLOCK - qi
    key_pos = (jnp.arange(nb)[:, None, None] - 1) * ATTN_BLOCK + si[None]
    valid = (jnp.abs(rel) <= WINDOW)[None] & (key_pos >= 0) & (key_pos < L)

    s_loc = jnp.einsum('bnqkgd,bnskd->bkgnqs', qb, kb, preferred_element_type=jnp.float32) * scale
    s_loc = jnp.where(valid, s_loc, -jnp.inf)
    s_ctx = jnp.einsum('bnqkgd,bckd->bkgnqc', qb, kc, preferred_element_type=jnp.float32) * scale
    mx = jnp.maximum(jnp.maximum(s_loc.max(-1, keepdims=True), s_ctx.max(-1, keepdims=True)), sink_l)
    p_loc = jnp.exp(s_loc - mx)
    p_ctx = jnp.exp(s_ctx - mx)
    denom = p_loc.sum(-1, keepdims=True) + p_ctx.sum(-1, keepdims=True) + jnp.exp(sink_l - mx)
    o = (jnp.einsum('bkgnqs,bnskd->bnqkgd', (p_loc / denom).astype(vb.dtype), vb)
         + jnp.einsum('bkgnqc,bckd->bnqkgd', (p_ctx / denom).astype(vc.dtype), vc))
    y = o.reshape(B, L, D) @ w_o + b_o

    yc = None
    if ctx_queries:
        qc = qkv_c[..., :qd].reshape(B, C, N_KV_HEADS, GROUP, HEAD_DIM)
        sc = jnp.einsum('bckgd,bekd->bkgce', qc, kc, preferred_element_type=jnp.float32) * scale
        sink_c = sink_l[..., 0, :, :]
        mxc = jnp.maximum(sc.max(-1, keepdims=True), sink_c)
        pc = jnp.exp(sc - mxc)
        den_c = pc.sum(-1, keepdims=True) + jnp.exp(sink_c - mxc)
        oc = jnp.einsum('bkgce,bekd->bckgd', (pc / den_c).astype(vc.dtype), vc)
        yc = oc.reshape(B, C, D) @ w_o + b_o
    return y, yc


def pool_mixer(u, w, b, scale):
    B, L, D = u.shape
    uf = u.astype(jnp.float32)
    csum = jnp.concatenate([jnp.zeros((B, 1, D), jnp.float32), jnp.cumsum(uf, axis=1)], axis=1)
    t = jnp.arange(L)
    parts = []
    for g, size in enumerate(POOL_SIZES):
        lo = jnp.clip(t - size // 2, 0, L)
        hi = jnp.clip(t - size // 2 + size, 0, L)
        cs = csum[..., g * POOL_GROUP:(g + 1) * POOL_GROUP]
        mean = (cs[:, hi] - cs[:, lo]) / (hi - lo).astype(jnp.float32)[:, None]
        parts.append(mean - uf[..., g * POOL_GROUP:(g + 1) * POOL_GROUP])
    y = jnp.stack(parts, axis=2).astype(u.dtype)
    y = jnp.einsum('blgc,gcd->blgd', y, w).reshape(B, L, D) + b
    return y * scale


def setup_inputs(seed: int = 0) -> dict:
    key = jax.random.key(seed)
    keys = iter(jax.random.split(key, 48))
    D = D_MODEL

    def nrm(shape, std):
        return jax.random.normal(next(keys), shape, jnp.float32) * std

    NH, NA, NP = N_HYENA_LAYERS, N_ATTN_LAYERS, N_POOL_LAYERS
    return {
        'x': nrm((BATCH, SEQ, D), 1.0),
        'c': nrm((BATCH, D), 1.0),
        'ctx': nrm((BATCH, CTX_LEN, D), 1.0),
        'c_ctx': nrm((D,), 1.0),
        'w_ada': nrm((DEPTH, D, N_MOD * D), 0.5 * D ** -0.5),
        'b_ada': nrm((DEPTH, N_MOD * D), 0.02),
        'norm_pre': 1.0 + nrm((DEPTH, 3, D), 0.05),
        'norm_post': 1.0 + nrm((DEPTH, 3, D), 0.05),
        'w_ffn_in': nrm((DEPTH, 2, D, 2 * D_FF), D ** -0.5),
        'w_ffn_out': nrm((DEPTH, 2, D_FF, D), D_FF ** -0.5),
        'hy_w_in': nrm((NH, D, 3 * D), D ** -0.5),
        'hy_b_in': nrm((NH, 3 * D), 0.02),
        'hy_w_sc': nrm((NH, 3, 3 * D), 0.5),
        'hy_b_sc': nrm((NH, 3 * D), 0.02),
        'hy_f_w1': nrm((NH, FILTER_EMB, FILTER_HIDDEN), FILTER_EMB ** -0.5),
        'hy_f_b1': nrm((NH, FILTER_HIDDEN), 0.1),
        'hy_f_w2': nrm((NH, FILTER_HIDDEN, FILTER_HIDDEN), FILTER_HIDDEN ** -0.5),
        'hy_f_b2': nrm((NH, FILTER_HIDDEN), 0.1),
        'hy_f_w3': nrm((NH, FILTER_HIDDEN, FILTER_HIDDEN), FILTER_HIDDEN ** -0.5),
        'hy_f_b3': nrm((NH, FILTER_HIDDEN), 0.1),
        'hy_f_w4': nrm((NH, FILTER_HIDDEN, 2 * D), FILTER_HIDDEN ** -0.5),
        'hy_f_freq': 1.0 + nrm((NH, 3, FILTER_HIDDEN), 0.1),
        'hy_skip': nrm((NH, D), 1.0),
        'hy_w_out': nrm((NH, D, D), D ** -0.5),
        'hy_b_out': nrm((NH, D), 0.02),
        'at_w_qkv': nrm((NA, D, QKV_DIM), D ** -0.5),
        'at_b_qkv': nrm((NA, QKV_DIM), 0.02),
        'at_sink': nrm((NA, N_HEADS), 0.5),
        'at_w_o': nrm((NA, D, D), D ** -0.5),
        'at_b_o': nrm((NA, D), 0.02),
        'pl_w': nrm((NP, len(POOL_SIZES), POOL_GROUP, POOL_GROUP), POOL_GROUP ** -0.5),
        'pl_b': nrm((NP, D), 0.02),
        'pl_scale': 1.0 + nrm((NP, D), 0.1),
    }


def reference(x, c, ctx, c_ctx, w_ada, b_ada, norm_pre, norm_post, w_ffn_in, w_ffn_out,
              hy_w_in, hy_b_in, hy_w_sc, hy_b_sc, hy_f_w1, hy_f_b1, hy_f_w2, hy_f_b2,
              hy_f_w3, hy_f_b3, hy_f_w4, hy_f_freq, hy_skip, hy_w_out, hy_b_out,
              at_w_qkv, at_b_qkv, at_sink, at_w_o, at_b_o,
              pl_w, pl_b, pl_scale):
    B, L, D = x.shape
    ROWS = L // GRID_W
    pos_row = jnp.broadcast_to(jnp.arange(ROWS)[:, None], (ROWS, GRID_W)).reshape(-1).astype(jnp.float32)
    pos_col = jnp.broadcast_to(jnp.arange(GRID_W)[None, :], (ROWS, GRID_W)).reshape(-1).astype(jnp.float32)
    inv_freq = ROPE_THETA ** (-jnp.arange(ROPE_PAIRS, dtype=jnp.float32) / ROPE_PAIRS)
    ang_row = pos_row[:, None] * inv_freq[None, :]
    ang_col = pos_col[:, None] * inv_freq[None, :]

    attn_layers = [i for i in range(DEPTH) if i % N_MIXERS == 1]
    last_ctx_layer = attn_layers[-1] if attn_layers else -1

    h, hc = x, ctx
    for i in range(DEPTH):
        kind, j = i % N_MIXERS, i // N_MIXERS
        ctx_live = i <= last_ctx_layer
        ctx_out = i < last_ctx_layer
        mod = (jax.nn.silu(c) @ w_ada[i] + b_ada[i]).reshape(B, N_MOD, 1, D)
        if ctx_live:
            mod_c = (jax.nn.silu(c_ctx) @ w_ada[i] + b_ada[i]).reshape(1, N_MOD, 1, D)

        h = gated_residual(h, swiglu(modulate(h, norm_pre[i, 0], mod, 0), w_ffn_in[i, 0], w_ffn_out[i, 0]),
                           norm_post[i, 0], mod, 0, FFN_RES)
        if ctx_live:
            hc = gated_residual(hc, swiglu(modulate(hc, norm_pre[i, 0], mod_c, 0), w_ffn_in[i, 0], w_ffn_out[i, 0]),
                                norm_post[i, 0], mod_c, 0, FFN_RES)

        u = modulate(h, norm_pre[i, 1], mod, 1)
        uc = modulate(hc, norm_pre[i, 1], mod_c, 1) if ctx_live else None
        yc = None
        if kind == 0:
            hp = (hy_w_in[j], hy_b_in[j], hy_w_sc[j], hy_b_sc[j], hy_f_w1[j], hy_f_b1[j], hy_f_w2[j], hy_f_b2[j],
                  hy_f_w3[j], hy_f_b3[j], hy_f_w4[j], hy_f_freq[j], hy_skip[j], hy_w_out[j], hy_b_out[j])
            y = hyena_mixer(u, *hp)
            if ctx_out:
                yc = hyena_mixer(uc, *hp)
        elif kind == 1:
            y, yc = windowed_gqa(u, uc, at_w_qkv[j], at_b_qkv[j], at_sink[j], at_w_o[j], at_b_o[j],
                                 ang_row, ang_col, ctx_out)
        else:
            y = pool_mixer(u, pl_w[j], pl_b[j], pl_scale[j])
            if ctx_out:
                yc = pool_mixer(uc, pl_w[j], pl_b[j], pl_scale[j])
        h = gated_residual(h, y, norm_post[i, 1], mod, 1, 1.0)
        if ctx_out:
            hc = gated_residual(hc, yc, norm_post[i, 1], mod_c, 1, 1.0)

        h = gated_residual(h, swiglu(modulate(h, norm_pre[i, 2], mod, 2), w_ffn_in[i, 1], w_ffn_out[i, 1]),
                           norm_post[i, 2], mod, 2, FFN_RES)
        if ctx_out:
            hc = gated_residual(hc, swiglu(modulate(hc, norm_pre[i, 2], mod_c, 2), w_ffn_in[i, 1], w_ffn_out[i, 1]),
                                norm_post[i, 2], mod_c, 2, FFN_RES)
    return h
```

```cpp
#include <hip/hip_runtime.h>
#include <cstdio>
#include <cstdint>
#include <cmath>
#include <cstddef>

#define LAS __attribute__((address_space(3)))
#define GAS __attribute__((address_space(1)))
#define CAS __attribute__((address_space(4)))
typedef unsigned short bf16_t;
typedef short bf16x8 __attribute__((ext_vector_type(8)));
typedef float f32x4 __attribute__((ext_vector_type(4)));
typedef float f32x2 __attribute__((ext_vector_type(2)));
typedef unsigned u32x4 __attribute__((ext_vector_type(4)));
typedef unsigned u32x2 __attribute__((ext_vector_type(2)));

constexpr int D = 2048, SEQ = 16384, CTX = 256, MT = SEQ + CTX, DEPTH = 4, DFF = 5632, NMOD = 9, QKVD = 3072;
constexpr int NWAVES = 8, NTHR = 512;
constexpr float NORM_EPS = 1e-6f;

constexpr size_t MiB = 1u << 20;
constexpr size_t WS_CTL = 0, CTL_ZERO_BYTES = 1 * MiB;
constexpr size_t WS_MOD = 1 * MiB;
constexpr size_t WS_ROPE = 2 * MiB;
constexpr size_t WS_HID = 3 * MiB;
constexpr size_t WS_FILTC = 15 * MiB;
constexpr size_t WS_FILT = 19 * MiB;
constexpr size_t WS_WIN = WS_FILT + 512 * MiB;
constexpr size_t WS_WOUT = WS_WIN + 352 * MiB;
constexpr size_t WS_WHIN = WS_WOUT + 176 * MiB;
constexpr size_t WS_WHOUT = WS_WHIN + 48 * MiB;
constexpr size_t WS_WQKV = WS_WHOUT + 16 * MiB;
constexpr size_t WS_WO = WS_WQKV + 12 * MiB;
constexpr size_t WS_WP = WS_WO + 8 * MiB;
constexpr size_t WS_H = WS_WP + 2 * MiB;
constexpr size_t WS_U = WS_H + 130 * MiB;
constexpr size_t WS_ACT = WS_U + 65 * MiB;
constexpr size_t WS_Y = WS_ACT + 179 * MiB;
constexpr size_t WS_ZT = WS_Y + 130 * MiB;
constexpr size_t WS_GT = WS_ZT + 195 * MiB;
constexpr size_t WS_END = WS_GT + 65 * MiB;
constexpr int CW_TMO = 0;
constexpr int CW_BAR = 4096;

constexpr int LDS_SCRATCH = 139264;
constexpr int MISC_OFF = LDS_SCRATCH;
constexpr int LDS_BYTES = 147456;

__device__ __forceinline__ unsigned cvt_pk_bf16(float lo, float hi) { unsigned r; asm volatile("v_cvt_pk_bf16_f32 %0, %1, %2" : "=v"(r) : "v"(lo), "v"(hi)); return r; }
__device__ __forceinline__ float bf2f(unsigned short b) { return __uint_as_float(((unsigned)b) << 16); }
__device__ __forceinline__ float bflo(unsigned w) { return __uint_as_float(w << 16); }
__device__ __forceinline__ float bfhi(unsigned w) { return __uint_as_float(w & 0xffff0000u); }
__device__ __forceinline__ bf16_t f2bf(float f) { return (bf16_t)(cvt_pk_bf16(f, 0.f) & 0xffffu); }
__device__ __forceinline__ float wave_sum(float v) {
#pragma unroll
    for (int o = 1; o < 64; o <<= 1) v += __shfl_xor(v, o);
    return v;
}
__device__ __forceinline__ float silu_f(float x) { return x * __builtin_amdgcn_rcpf(1.f + __builtin_amdgcn_exp2f(-1.4426950408889634f * x)); }
#define LDS_WAIT() asm volatile("s_waitcnt lgkmcnt(0)" ::: "memory")
#define VM_WAIT() asm volatile("s_waitcnt vmcnt(0)" ::: "memory")

namespace pg8 {
constexpr int BM = 256, BK = 64, HALF = 128, HTB = HALF * BK * 2, STAGE_BYTES = 8 * HTB, NXCD = 8, WGM = 8;
__host__ __device__ __forceinline__ int lds_byte(int r, int c) { const int st = (r >> 4) * 2 + (c >> 5), rr = r & 15, cc = c & 31, ob = rr * 64 + cc * 2; return st * 1024 + (ob ^ (((ob >> 9) & 1) << 5)); }
__host__ __device__ __forceinline__ void stage_rc(int b, int& R, int& C) { const int st = b / 1024, sb = b % 1024, swz = sb ^ (((sb >> 9) & 1) << 5); R = (st >> 1) * 16 + swz / 64; C = (st & 1) * 32 + (swz % 64) / 2; }
__host__ __device__ __forceinline__ int perm32(int rho) { const int n = rho >> 4, i = rho & 15; return 8 * (i >> 2) + 4 * n + (i & 3); }

struct Unit { int pm, pn; };
struct Gemm { const bf16_t* A; const bf16_t* Bt; int M, N, K, lda, ldb, a_shift, a_step; };

struct StaticOrder {
    int nM, nN, nwg, G, c;
    __device__ void init(int M, int N, int G_, int c_) { nM = M / BM; nN = N / BM; nwg = nM * nN; G = G_; c = c_; }
    __device__ bool next(int i, Unit& u) const {
        const long L = (long)i * G + c; if (L >= nwg) return false;
        int wgid = (int)L; { const int q = nwg / NXCD, r = nwg % NXCD, xcd = wgid % NXCD, off = wgid / NXCD; wgid = (xcd < r ? xcd * (q + 1) : r * (q + 1) + (xcd - r) * q) + off; }
        const int nig = WGM * nN, gid = wgid / nig, fm = gid * WGM, gsz = (nM - fm) < WGM ? (nM - fm) : WGM;
        u.pm = fm + ((wgid % nig) % gsz); u.pn = (wgid % nig) / gsz; return true;
    }
};

struct EpiSwiGLU {
    static constexpr bool PERM = true;
    bf16_t* O; int ldc;
    __device__ __forceinline__ void operator()(const f32x4 (&acc)[2][2][4][2], const Unit& u, int wr, int wc, int fr, int fq) const {
        const int row0 = u.pm * BM + wr * 64 + fr, col0 = u.pn * HALF + wc * 32 + 8 * fq;
#pragma unroll
        for (int ai = 0; ai < 2; ++ai)
#pragma unroll
            for (int m = 0; m < 4; ++m) { bf16_t* rowp = O + (size_t)(row0 + ai * HALF + m * 16) * ldc + col0;
                const f32x4 g0 = acc[ai][0][m][0], g1 = acc[ai][0][m][1], u0 = acc[ai][1][m][0], u1 = acc[ai][1][m][1];
                u32x4 w;
                w.x = cvt_pk_bf16(silu_f(g0[0]) * u0[0], silu_f(g0[1]) * u0[1]); w.y = cvt_pk_bf16(silu_f(g0[2]) * u0[2], silu_f(g0[3]) * u0[3]);
                w.z = cvt_pk_bf16(silu_f(g1[0]) * u1[0], silu_f(g1[1]) * u1[1]); w.w = cvt_pk_bf16(silu_f(g1[2]) * u1[2], silu_f(g1[3]) * u1[3]);
                *(u32x4*)rowp = w; }
    }
};
struct EpiF32 {
    static constexpr bool PERM = false;
    float* C; int ldc; const float* bias; const float* scale;
    __device__ __forceinline__ void operator()(const f32x4 (&acc)[2][2][4][2], const Unit& u, int wr, int wc, int fr, int fq) const {
        const int row0 = u.pm * BM + wr * 64 + fr, col0 = u.pn * BM + wc * 32 + 4 * fq;
        f32x4 bv[2][2], sv[2][2];
#pragma unroll
        for (int bj = 0; bj < 2; ++bj)
#pragma unroll
            for (int n = 0; n < 2; ++n) { bv[bj][n] = bias ? *(const f32x4*)(bias + col0 + bj * HALF + n * 16) : (f32x4){0.f, 0.f, 0.f, 0.f};
                sv[bj][n] = scale ? *(const f32x4*)(scale + col0 + bj * HALF + n * 16) : (f32x4){1.f, 1.f, 1.f, 1.f}; }
#pragma unroll
        for (int ai = 0; ai < 2; ++ai)
#pragma unroll
            for (int m = 0; m < 4; ++m) { float* rowp = C + (size_t)(row0 + ai * HALF + m * 16) * ldc + col0;
#pragma unroll
                for (int bj = 0; bj < 2; ++bj)
#pragma unroll
                    for (int n = 0; n < 2; ++n) *(f32x4*)(rowp + bj * HALF + n * 16) = (acc[ai][bj][m][n] + bv[bj][n]) * sv[bj][n]; }
    }
};
struct EpiBf16 {
    static constexpr bool PERM = true;
    bf16_t* O; int ldc; const float* cbias; const float* rbias;
    __device__ __forceinline__ void operator()(const f32x4 (&acc)[2][2][4][2], const Unit& u, int wr, int wc, int fr, int fq) const {
        const int row0 = u.pm * BM + wr * 64 + fr, col0 = u.pn * BM + wc * 32 + 8 * fq;
        f32x4 bv[2][2];
#pragma unroll
        for (int bj = 0; bj < 2; ++bj)
#pragma unroll
            for (int n = 0; n < 2; ++n) bv[bj][n] = cbias ? *(const f32x4*)(cbias + col0 + bj * HALF + 4 * n) : (f32x4){0.f, 0.f, 0.f, 0.f};
#pragma unroll
        for (int ai = 0; ai < 2; ++ai)
#pragma unroll
            for (int m = 0; m < 4; ++m) { const int row = row0 + ai * HALF + m * 16; bf16_t* rowp = O + (size_t)row * ldc + col0; const float rb = rbias ? rbias[row] : 0.f;
#pragma unroll
                for (int bj = 0; bj < 2; ++bj) { const f32x4 v0 = acc[ai][bj][m][0] + bv[bj][0] + rb, v1 = acc[ai][bj][m][1] + bv[bj][1] + rb;
                    u32x4 w; w.x = cvt_pk_bf16(v0[0], v0[1]); w.y = cvt_pk_bf16(v0[2], v0[3]); w.z = cvt_pk_bf16(v1[0], v1[1]); w.w = cvt_pk_bf16(v1[2], v1[3]);
                    *(u32x4*)(rowp + bj * HALF) = w; } }
    }
};

template <class Epi>
__device__ __forceinline__ void gemm_phase(LAS unsigned char* lds, const Gemm g, const StaticOrder& S, const Epi& E) {
    int tid_ = threadIdx.x; asm volatile("" : "+v"(tid_));
    const int tid = tid_, wid = __builtin_amdgcn_readfirstlane(tid >> 6), lane = tid & 63, wr = wid >> 2, wc = wid & 3, fr = lane & 15, fq = lane >> 4;
    const int K = g.K, nt = K / BK;
    unsigned voffA[2], voffB[2];
#pragma unroll
    for (int i = 0; i < 2; ++i) { int R, C; stage_rc(tid * 16 + i * 8192, R, C); const int Rb = Epi::PERM ? ((R & ~31) + perm32(R & 31)) : R;
        voffA[i] = (unsigned)(R * g.lda + C) * 2u; voffB[i] = (unsigned)(Rb * g.ldb + C) * 2u; }
    const size_t kstep = (size_t)(BK * 2);
    const size_t hstepA = (size_t)HALF * g.lda * 2, hstepB = (size_t)HALF * g.ldb * 2;
    const size_t tstepA = 2 * hstepA, tstepB = 2 * hstepB;
    const unsigned ldsw = (unsigned)wid * 1024u;
    const int aoff = lds_byte(wr * 64 + fr, fq * 8), boff = lds_byte(wc * 32 + fr, fq * 8);
#define PG8_SA(b, h) (((b) * 2 + (h)) * HTB)
#define PG8_SB(b, h) ((4 + (b) * 2 + (h)) * HTB)
#define PG8_STAGE(bufoff, gbase, voff) do { _Pragma("unroll") for (int _i = 0; _i < 2; ++_i) \
        __builtin_amdgcn_global_load_lds((const unsigned*)((const char*)(gbase) + (voff)[_i]), (LAS unsigned*)(lds + (bufoff) + ldsw + _i * 8192), 16, 0, 0); } while (0)
#define PG8_LDA(dst, b, h) do { _Pragma("unroll") for (int m = 0; m < 4; ++m) _Pragma("unroll") for (int k = 0; k < 2; ++k) dst[m][k] = *(const LAS bf16x8*)(lds + PG8_SA(b, h) + aoff + m * 2048 + k * 1024); } while (0)
#define PG8_LDB(dst, b, h) do { _Pragma("unroll") for (int n = 0; n < 2; ++n) _Pragma("unroll") for (int k = 0; k < 2; ++k) dst[n][k] = *(const LAS bf16x8*)(lds + PG8_SB(b, h) + boff + n * 2048 + k * 1024); } while (0)
#define PG8_MMA(ai, bj, At, Bt) do { __builtin_amdgcn_s_setprio(1); _Pragma("unroll") for (int m = 0; m < 4; ++m) _Pragma("unroll") for (int n = 0; n < 2; ++n) _Pragma("unroll") for (int k = 0; k < 2; ++k) \
        acc[ai][bj][m][n] = __builtin_amdgcn_mfma_f32_16x16x32_bf16(Bt[n][k], At[m][k], acc[ai][bj][m][n], 0, 0, 0); __builtin_amdgcn_s_setprio(0); } while (0)
#define PG8_WAIT_V(n) asm volatile("s_waitcnt vmcnt(" #n ")" ::: "memory")
#define PG8_WAIT_L(n) asm volatile("s_waitcnt lgkmcnt(" #n ")" ::: "memory")
#define PG8_BAR __builtin_amdgcn_s_barrier()
#define PG8_SCHED __builtin_amdgcn_sched_barrier(0)
    Unit cur, nxt; int ui = 0;
    if (!S.next(0, cur)) return;
    f32x4 acc[2][2][4][2];
#pragma unroll
    for (int a = 0; a < 2; ++a)
#pragma unroll
        for (int b = 0; b < 2; ++b)
#pragma unroll
            for (int m = 0; m < 4; ++m)
#pragma unroll
                for (int n = 0; n < 2; ++n) acc[a][b][m][n] = (f32x4){0.f, 0.f, 0.f, 0.f};
    bf16x8 At[4][2], B0[2][2], B1[2][2];
    const char* cA = (const char*)g.A + (size_t)cur.pm * tstepA + (size_t)((cur.pn >> g.a_shift) * g.a_step) * 2; const char* cB = (const char*)g.Bt + (size_t)cur.pn * tstepB;
    PG8_STAGE(PG8_SB(0, 0), cB, voffB); PG8_STAGE(PG8_SB(0, 1), cB + hstepB, voffB); PG8_STAGE(PG8_SA(0, 0), cA, voffA); PG8_STAGE(PG8_SA(0, 1), cA + hstepA, voffA);
    if (wr == 1) PG8_BAR;
    PG8_WAIT_V(2); PG8_BAR;
    PG8_STAGE(PG8_SB(1, 0), cB + kstep, voffB); PG8_STAGE(PG8_SA(1, 0), cA + kstep, voffA); PG8_STAGE(PG8_SB(1, 1), cB + hstepB + kstep, voffB);
    PG8_WAIT_V(6); PG8_BAR;
    for (;;) {
        const bool has_next = S.next(ui + 1, nxt);
        const char* nA = has_next ? (const char*)g.A + (size_t)nxt.pm * tstepA + (size_t)((nxt.pn >> g.a_shift) * g.a_step) * 2 : cA; const char* nB = has_next ? (const char*)g.Bt + (size_t)nxt.pn * tstepB : cB;
        for (int t = 0; t < nt; t += 2) {
            const bool last = (t == nt - 2);
            const char* a1 = cA + (size_t)(t + 1) * kstep;
            const char* a2 = last ? nA : cA + (size_t)(t + 2) * kstep; const char* b2 = last ? nB : cB + (size_t)(t + 2) * kstep;
            const char* a3 = a2 + kstep; const char* b3 = b2 + kstep;
            PG8_LDB(B0, 0, 0); PG8_LDB(B1, 0, 1); PG8_SCHED; PG8_LDA(At, 0, 0); PG8_STAGE(PG8_SA(1, 1), a1 + hstepA, voffA);
            PG8_WAIT_V(8); PG8_WAIT_L(0); PG8_BAR; PG8_MMA(0, 0, At, B0); PG8_MMA(0, 1, At, B1); PG8_BAR; PG8_SCHED;
            PG8_LDA(At, 0, 1); PG8_STAGE(PG8_SB(0, 0), b2, voffB); PG8_STAGE(PG8_SB(0, 1), b2 + hstepB, voffB); PG8_STAGE(PG8_SA(0, 0), a2, voffA);
            PG8_WAIT_V(8); PG8_WAIT_L(0); PG8_BAR; PG8_MMA(1, 0, At, B0); PG8_MMA(1, 1, At, B1); PG8_BAR; PG8_SCHED;
            PG8_LDB(B0, 1, 0); PG8_LDB(B1, 1, 1); PG8_SCHED; PG8_LDA(At, 1, 0); PG8_STAGE(PG8_SA(0, 1), a2 + hstepA, voffA);
            PG8_WAIT_V(8); PG8_WAIT_L(0); PG8_BAR; PG8_MMA(0, 0, At, B0); PG8_MMA(0, 1, At, B1); PG8_BAR; PG8_SCHED;
            PG8_LDA(At, 1, 1); PG8_STAGE(PG8_SB(1, 0), b3, voffB); PG8_STAGE(PG8_SB(1, 1), b3 + hstepB, voffB); PG8_STAGE(PG8_SA(1, 0), a3, voffA);
            PG8_WAIT_V(8); PG8_WAIT_L(0); PG8_BAR; PG8_MMA(1, 0, At, B0); PG8_MMA(1, 1, At, B1); PG8_BAR; PG8_SCHED;
        }
        if (wr == 0) PG8_BAR;
        E(acc, cur, wr, wc, fr, fq);
        if (!has_next) break;
#pragma unroll
        for (int a = 0; a < 2; ++a)
#pragma unroll
            for (int b = 0; b < 2; ++b)
#pragma unroll
                for (int m = 0; m < 4; ++m)
#pragma unroll
                    for (int n = 0; n < 2; ++n) acc[a][b][m][n] = (f32x4){0.f, 0.f, 0.f, 0.f};
        cur = nxt; cA = nA; cB = nB; ++ui;
        if (wr == 1) PG8_BAR;
    }
    PG8_WAIT_V(0);
    PG8_BAR;
#undef PG8_SA
#undef PG8_SB
#undef PG8_STAGE
#undef PG8_LDA
#undef PG8_LDB
#undef PG8_MMA
#undef PG8_WAIT_V
#undef PG8_WAIT_L
#undef PG8_BAR
#undef PG8_SCHED
}
}

#define XB_TMO      128
#define XB_XCNT(j)  (256  + 64 * (j))
#define XB_XSUB(j)  (1280 + 64 * (j))
#define XB_XGEN(j)  (2304 + 64 * (j))
#define XB_TOP      3328
#define XB_TOPGEN   3392
#define XCD_BAR_WORDS 3456
#define XB_SPIN_CAP (1u << 18)
__device__ __forceinline__ unsigned xb_ld(unsigned* p)              { return __hip_atomic_load(p, __ATOMIC_RELAXED, __HIP_MEMORY_SCOPE_AGENT); }
__device__ __forceinline__ unsigned xb_add(unsigned* p, unsigned v) { return __hip_atomic_fetch_add(p, v, __ATOMIC_RELAXED, __HIP_MEMORY_SCOPE_AGENT); }
__device__ __forceinline__ unsigned xb_xcc_id() { return (unsigned)__builtin_amdgcn_s_getreg((3 << 11) | 20) & 0xFu; }
#define XB_SPIN(cond, bar) do { unsigned _sp = 0; while (cond) { __builtin_amdgcn_s_sleep(1); \
    if ((++_sp & 255u) == 0u) { if (xb_ld(&(bar)[XB_TMO])) break; if (_sp > XB_SPIN_CAP) { atomicAdd(&(bar)[XB_TMO], 1u); break; } } } } while (0)
struct XcdBarrier { unsigned* bar; unsigned x; volatile LAS unsigned* st; };
__device__ __forceinline__ XcdBarrier xcd_barrier_post(unsigned* bar, volatile LAS unsigned* st) {
    XcdBarrier b; b.bar = bar; b.x = xb_xcc_id(); b.st = st;
    if (threadIdx.x == 0) (void)xb_add(&bar[XB_XCNT(b.x)], 1u);
    return b;
}
__device__ __forceinline__ void xcd_barrier_complete(unsigned* bar, unsigned x, unsigned& nloc, unsigned& nx) {
    const unsigned G = gridDim.x * gridDim.y * gridDim.z;
    unsigned sum, cnt, mine, sp = 0u;
    for (;;) {
        sum = 0u; cnt = 0u; mine = 0u;
#pragma unroll
        for (unsigned j = 0; j < 16; ++j) { const unsigned c = xb_ld(&bar[XB_XCNT(j)]); sum += c; cnt += (c > 0u) ? 1u : 0u; mine = (j == x) ? c : mine; }
        if (sum == G) break;
        __builtin_amdgcn_s_sleep(1);
        if ((++sp & 255u) == 0u) { if (xb_ld(&bar[XB_TMO])) break; if (sp > XB_SPIN_CAP) { atomicAdd(&bar[XB_TMO], 1u); break; } }
    }
    nloc = mine > 0u ? mine : 1u; nx = cnt > 0u ? cnt : 1u;
}
__device__ __forceinline__ void xcd_barrier(const XcdBarrier& b) {
    asm volatile("s_waitcnt vmcnt(0)" ::: "memory");
    __syncthreads();
    if (threadIdx.x == 0) {
        unsigned* bar = b.bar;
        __builtin_amdgcn_s_waitcnt(0);
        unsigned nloc = b.st[0], nx = b.st[1];
        if (nloc == 0u) { xcd_barrier_complete(bar, b.x, nloc, nx); b.st[0] = nloc; b.st[1] = nx; }
        const unsigned old = xb_add(&bar[XB_XSUB(b.x)], 1u);
        const unsigned gen = old / nloc;
        if (old + 1u == (gen + 1u) * nloc) {
            __builtin_amdgcn_fence(__ATOMIC_RELEASE, "agent");
            asm volatile("s_waitcnt vmcnt(0)" ::: "memory");
            const unsigned og = xb_add(&bar[XB_TOP], 1u);
            const unsigned tg = og / nx;
            if (og + 1u == (tg + 1u) * nx) xb_add(&bar[XB_TOPGEN], 1u);
            else XB_SPIN(xb_ld(&bar[XB_TOPGEN]) == tg, bar);
            __builtin_amdgcn_fence(__ATOMIC_ACQUIRE, "agent");
            xb_add(&bar[XB_XGEN(b.x)], 1u);
            asm volatile("s_waitcnt vmcnt(0)" ::: "memory");
        } else {
            XB_SPIN(xb_ld(&bar[XB_XGEN(b.x)]) == gen, bar);
            __builtin_amdgcn_fence(__ATOMIC_ACQUIRE, "agent");
            asm volatile("s_waitcnt vmcnt(0)" ::: "memory");
        }
    }
    __syncthreads();
}

namespace fftc {
typedef float cf __attribute__((ext_vector_type(2)));
constexpr int LOGM = 14, FM = 1 << LOGM;
constexpr int FPHYS = FM + (FM >> 6) * 4;
#define FD __device__ __forceinline__
FD float hw_sin_rev(float f) { return __builtin_amdgcn_sinf(f); }
FD float hw_cos_rev(float f) { return __builtin_amdgcn_cosf(f); }
FD int phys(int i) { return i + ((i >> 6) << 2); }
FD cf cadd(cf a, cf b) { return a + b; }
FD cf csub(cf a, cf b) { return a - b; }
FD cf cmul(cf a, cf b) { return (cf){a.x * b.x - a.y * b.y, a.x * b.y + a.y * b.x}; }
FD cf cconj(cf a) { return (cf){a.x, -a.y}; }
FD cf c16(int m) {
    constexpr float C[8] = {1.0f, 0.9238795325112867f, 0.7071067811865476f, 0.3826834323650898f, 0.0f, -0.3826834323650898f, -0.7071067811865476f, -0.9238795325112867f};
    constexpr float S[8] = {0.0f, 0.3826834323650898f, 0.7071067811865476f, 0.9238795325112867f, 1.0f, 0.9238795325112867f, 0.7071067811865476f, 0.3826834323650898f};
    return (cf){C[m], -S[m]};
}
FD cf twid(int e) { const float f = (float)(e & (FM - 1)) * (1.0f / (float)FM); return (cf){hw_cos_rev(f), -hw_sin_rev(f)}; }
FD int rev14(int p) { return (int)(__builtin_bitreverse32((unsigned)p) >> (32 - LOGM)); }
template <int S0, int G, bool INV, int NT>
FD void fft_pass(LAS cf* X, int tid) {
    constexpr int R = 1 << G;
    constexpr int LOGHG = LOGM - S0 - G, HG = 1 << LOGHG;
    constexpr int NGRP = FM >> G;
    for (int gid = tid; gid < NGRP; gid += NT) {
        const int lo = gid & (HG - 1), hi = gid >> LOGHG, base = (hi << (LOGHG + G)) + lo;
        cf v[R];
#pragma unroll
        for (int q = 0; q < R; ++q) v[q] = X[phys(base + q * HG)];
        if (!INV) {
#pragma unroll
            for (int st = 0; st < G; ++st) {
                const int dq = R >> (st + 1);
                cf T = (cf){1.f, 0.f};
                if (HG > 1) T = twid(lo << (S0 + st));
#pragma unroll
                for (int q = 0; q < R; ++q) if ((q & dq) == 0) {
                    const int qq = q & (dq - 1), m = qq * 8 / dq;
                    const cf a = v[q], b = v[q + dq];
                    v[q] = cadd(a, b);
                    cf d = csub(a, b);
                    if (m != 0) d = cmul(d, c16(m));
                    if (HG > 1) d = cmul(d, T);
                    v[q + dq] = d;
                }
            }
        } else {
#pragma unroll
            for (int st = G - 1; st >= 0; --st) {
                const int dq = R >> (st + 1);
                cf T = (cf){1.f, 0.f};
                if (HG > 1) T = cconj(twid(lo << (S0 + st)));
#pragma unroll
                for (int q = 0; q < R; ++q) if ((q & dq) == 0) {
                    const int qq = q & (dq - 1), m = qq * 8 / dq;
                    const cf a = v[q]; cf b = v[q + dq];
                    if (m != 0) b = cmul(b, cconj(c16(m)));
                    if (HG > 1) b = cmul(b, T);
                    v[q] = cadd(a, b);
                    v[q + dq] = csub(a, b);
                }
            }
        }
#pragma unroll
        for (int q = 0; q < R; ++q) X[phys(base + q * HG)] = v[q];
    }
}
FD void pair_pos(int q, int& p, int& p2, int& k) { p = 2 * q; k = rev14(p); p2 = rev14((FM - k) & (FM - 1)); }
FD cf wk2(int k) { const float f = (float)k * (0.5f / (float)FM); return (cf){hw_cos_rev(f), -hw_sin_rev(f)}; }
FD void real_unpack(cf Zk, cf Zk2, int k, cf& Xk, cf& Xmk) {
    const cf E = (cf){0.5f * (Zk.x + Zk2.x), 0.5f * (Zk.y - Zk2.y)};
    const cf O = (cf){0.5f * (Zk.y + Zk2.y), -0.5f * (Zk.x - Zk2.x)};
    const cf WO = cmul(wk2(k), O);
    Xk = cadd(E, WO); Xmk = cconj(csub(E, WO));
}
FD void real_pack(cf Yk, cf Ymk, int k, cf& Zk, cf& Zk2) {
    const cf Ey = (cf){0.5f * (Yk.x + Ymk.x), 0.5f * (Yk.y - Ymk.y)};
    const cf Dd = (cf){0.5f * (Yk.x - Ymk.x), 0.5f * (Yk.y + Ymk.y)};
    const cf Oy = cmul(cconj(wk2(k)), Dd);
    Zk = (cf){Ey.x - Oy.y, Ey.y + Oy.x};
    Zk2 = (cf){Ey.x + Oy.y, -Ey.y + Oy.x};
}
FD void fft_forward(LAS cf* X, int tid) {
    fft_pass<0, 4, false, NTHR>(X, tid); __syncthreads();
    fft_pass<4, 4, false, NTHR>(X, tid); __syncthreads();
    fft_pass<8, 4, false, NTHR>(X, tid); __syncthreads();
    fft_pass<12, 2, false, NTHR>(X, tid); __syncthreads();
}
FD void fft_inverse(LAS cf* X, int tid) {
    fft_pass<12, 2, true, NTHR>(X, tid); __syncthreads();
    fft_pass<8, 4, true, NTHR>(X, tid); __syncthreads();
    fft_pass<4, 4, true, NTHR>(X, tid); __syncthreads();
    fft_pass<0, 4, true, NTHR>(X, tid); __syncthreads();
}
}

struct Args {
    const float* in[33]; float* out; unsigned char* ws;
    double invf[32];
};
enum { I_X = 0, I_C, I_CTX, I_CCTX, I_WADA, I_BADA, I_NPRE, I_NPOST, I_WFIN, I_WFOUT, I_HWIN, I_HBIN, I_HWSC, I_HBSC, I_FW1, I_FB1, I_FW2, I_FB2, I_FW3, I_FB3, I_FW4, I_FFREQ, I_HSKIP, I_HWOUT, I_HBOUT,
       I_AWQKV, I_ABQKV, I_ASINK, I_AWO, I_ABO, I_PW, I_PB, I_PSCALE };

__device__ __forceinline__ const CAS char* kargs() { const CAS char* p = (const CAS char*)__builtin_amdgcn_kernarg_segment_ptr(); asm volatile("" : "+s"(p)); return p; }
#define IN(i) (*(const float* const CAS*)(kargs() + 8 * (i)))
#define OUTP (*(float* const CAS*)(kargs() + 8 * 33))
#define WSP (*(unsigned char* const CAS*)(kargs() + 8 * 34))
#define INVF(j) (*(const CAS double*)(kargs() + 8 * 35 + 8 * (j)))
struct Frame {
    LAS unsigned char* lds;
    int tid, lane, wave, G, bid;
    unsigned char* ws;
};
__device__ __forceinline__ Frame mk_frame() {
    extern __shared__ __attribute__((aligned(16))) unsigned char lds_raw[];
    Frame F; int tid = threadIdx.x; asm volatile("" : "+v"(tid));
    F.lds = (LAS unsigned char*)lds_raw; F.tid = tid; F.lane = tid & 63; F.wave = __builtin_amdgcn_readfirstlane(tid >> 6);
    F.G = gridDim.x; F.bid = blockIdx.x; F.ws = WSP; return F;
}

__device__ __forceinline__ void cvt_item(const float* W, int K, int N, bf16_t* WT, int mode, LAS float* scr, int item, int lane) {
    const int nblk = N / 32, kb = item / nblk, nb = item % nblk, k0 = 64 * kb, r0 = 32 * nb;
    int n0 = r0;
    if (mode == 1) { const int pn = r0 >> 8, w = r0 & 255; n0 = (w < 128) ? (128 * pn + w) : (DFF + 128 * pn + (w - 128)); }
#pragma unroll 8
    for (int i = 0; i < 32; ++i) { const int kk = 2 * i + (lane >> 5); scr[kk * 33 + (lane & 31)] = W[(size_t)(k0 + kk) * N + n0 + (lane & 31)]; }
    LDS_WAIT(); asm volatile("" ::: "memory");
    const int c = lane & 7;
#pragma unroll
    for (int j = 0; j < 4; ++j) { const int n = (lane >> 3) + 8 * j; const LAS float* s = scr + (8 * c) * 33 + n;
        u32x4 o; o.x = cvt_pk_bf16(s[0 * 33], s[1 * 33]); o.y = cvt_pk_bf16(s[2 * 33], s[3 * 33]); o.z = cvt_pk_bf16(s[4 * 33], s[5 * 33]); o.w = cvt_pk_bf16(s[6 * 33], s[7 * 33]);
        *(u32x4*)(WT + (size_t)(r0 + n) * K + k0 + 8 * c) = o; }
    LDS_WAIT(); asm volatile("" ::: "memory");
}
__device__ __forceinline__ void p0_convert(const Frame& F) {
    LAS float* scr = (LAS float*)(F.lds + F.wave * 8704);
    const int gw = F.bid * NWAVES + F.wave, NGW = F.G * NWAVES;
    constexpr int I_IN = (D / 64) * (2 * DFF / 32), I_OUT = (DFF / 64) * (D / 32), I_HI = (D / 64) * (3 * D / 32), I_SQ = (D / 64) * (D / 32), I_QK = (D / 64) * (QKVD / 32), I_PL = (512 / 64) * (512 / 32);
    constexpr int E0 = 8 * I_IN, E1 = E0 + 8 * I_OUT, E2 = E1 + 2 * I_HI, E3 = E2 + 2 * I_SQ, E4 = E3 + I_QK, E5 = E4 + I_SQ, E6 = E5 + 4 * I_PL;
    for (int it = gw; it < E6; it += NGW) {
        if (it < E0) { const int j = it / I_IN, r = it % I_IN; cvt_item(IN(I_WFIN) + (size_t)j * D * 2 * DFF, D, 2 * DFF, (bf16_t*)(F.ws + WS_WIN) + (size_t)j * 2 * DFF * D, 1, scr, r, F.lane); }
        else if (it < E1) { const int j = (it - E0) / I_OUT, r = (it - E0) % I_OUT; cvt_item(IN(I_WFOUT) + (size_t)j * DFF * D, DFF, D, (bf16_t*)(F.ws + WS_WOUT) + (size_t)j * D * DFF, 0, scr, r, F.lane); }
        else if (it < E2) { const int j = (it - E1) / I_HI, r = (it - E1) % I_HI; cvt_item(IN(I_HWIN) + (size_t)j * D * 3 * D, D, 3 * D, (bf16_t*)(F.ws + WS_WHIN) + (size_t)j * 3 * D * D, 0, scr, r, F.lane); }
        else if (it < E3) { const int j = (it - E2) / I_SQ, r = (it - E2) % I_SQ; cvt_item(IN(I_HWOUT) + (size_t)j * D * D, D, D, (bf16_t*)(F.ws + WS_WHOUT) + (size_t)j * D * D, 0, scr, r, F.lane); }
        else if (it < E4) { cvt_item(IN(I_AWQKV), D, QKVD, (bf16_t*)(F.ws + WS_WQKV), 0, scr, it - E3, F.lane); }
        else if (it < E5) { cvt_item(IN(I_AWO), D, D, (bf16_t*)(F.ws + WS_WO), 0, scr, it - E4, F.lane); }
        else { const int j = (it - E5) / I_PL, r = (it - E5) % I_PL; cvt_item(IN(I_PW) + (size_t)j * 512 * 512, 512, 512, (bf16_t*)(F.ws + WS_WP) + (size_t)j * 512 * 512, 0, scr, r, F.lane); }
    }
}

__device__ __forceinline__ void p0_mods(const Frame& F) {
    LAS float* sc = (LAS float*)(F.lds + 69632);
    LAS float* red = sc + 4096;
    { const float* cp = IN(I_C); const float* ccp = IN(I_CCTX);
      for (int i = F.tid; i < D; i += NTHR) { sc[i] = silu_f(cp[i]); sc[D + i] = silu_f(ccp[i]); } }
    __syncthreads();
    float* mod = (float*)(F.ws + WS_MOD); float* modc = (float*)(F.ws + WS_MOD + 512 * 1024);
    const float* bada = IN(I_BADA); const float* wada = IN(I_WADA);
    constexpr int NCB = NMOD * D / 256;
    for (int it = F.bid; it < DEPTH * NCB; it += F.G) {
        const int l = it / NCB, cb = it % NCB;
        const float* wp = wada + ((size_t)l * D + (size_t)F.wave * 256) * (NMOD * D) + cb * 256 + 4 * F.lane;
        f32x4 a0 = {0.f, 0.f, 0.f, 0.f}, a1 = {0.f, 0.f, 0.f, 0.f};
#pragma unroll 8
        for (int k = 0; k < 256; ++k) { const f32x4 w = *(const f32x4*)(wp + (size_t)k * (NMOD * D)); const float s0 = sc[F.wave * 256 + k], s1 = sc[D + F.wave * 256 + k]; a0 += w * s0; a1 += w * s1; }
        *(LAS f32x4*)(red + (F.wave * 2 + 0) * 256 + 4 * F.lane) = a0;
        *(LAS f32x4*)(red + (F.wave * 2 + 1) * 256 + 4 * F.lane) = a1;
        __syncthreads();
        { const int s = F.tid >> 8, col = F.tid & 255; float v = 0.f;
#pragma unroll
            for (int w = 0; w < 8; ++w) v += red[(w * 2 + s) * 256 + col];
            const int j = cb * 256 + col; v += bada[l * (NMOD * D) + j];
            if (s == 0) mod[l * (NMOD * D) + j] = v; else if (l < 2) modc[l * (NMOD * D) + j] = v; }
        __syncthreads();
    }
}

__device__ __forceinline__ void p0_rope(const Frame& F) {
    f32x2* tab = (f32x2*)(F.ws + WS_ROPE);
    for (int i = F.bid * NTHR + F.tid; i < 256 * 32; i += F.G * NTHR) {
        const int pos = i >> 5, j = i & 31;
        const double rev = (double)pos * INVF(j) * 0.15915494309189535;
        const float fr = (float)(rev - floor(rev));
        tab[i] = (f32x2){__builtin_amdgcn_cosf(fr), __builtin_amdgcn_sinf(fr)};
    }
}

__device__ __forceinline__ float sin_rad(float x) { const float r = x * 0.15915494309189535f; return __builtin_amdgcn_sinf(r - floorf(r)); }
__device__ __forceinline__ void p0_hidden(const Frame& F) {
    LAS float* hb = (LAS float*)(F.lds + 102400 + F.wave * 512);
    constexpr int NB0 = SEQ / 8, NB2 = CTX / 8;
    for (int it = F.bid; it < 2 * NB0 + NB2; it += F.G) {
        int set, tb; if (it < NB0) { set = 0; tb = it; } else if (it < 2 * NB0) { set = 1; tb = it - NB0; } else { set = 2; tb = it - 2 * NB0; }
        const int hj = (set == 1) ? 1 : 0, L = (set == 2) ? CTX : SEQ, t = tb * 8 + F.wave, lane = F.lane;
        const float* w1 = IN(I_FW1) + hj * 33 * 64; const float* b1 = IN(I_FB1) + hj * 64;
        const float* w2 = IN(I_FW2) + hj * 64 * 64; const float* b2 = IN(I_FB2) + hj * 64;
        const float* w3 = IN(I_FW3) + hj * 64 * 64; const float* b3 = IN(I_FB3) + hj * 64;
        const float* fq = IN(I_FFREQ) + hj * 3 * 64;
        if (lane < 33) {
            float z;
            if (lane == 0) z = (float)t / (float)(L - 1);
            else { const int bi = (lane - 1) & 15; const double band = 1e-4 + (double)bi * ((15.0 - 1e-4) / 15.0); const double rev = band * (double)t / (double)L; const float fr = (float)(rev - floor(rev));
                z = (lane <= 16) ? __builtin_amdgcn_cosf(fr) : -__builtin_amdgcn_sinf(fr); }
            hb[lane] = z;
        }
        LDS_WAIT(); __builtin_amdgcn_wave_barrier();
        float acc = b1[lane];
#pragma unroll 11
        for (int i = 0; i < 33; ++i) acc += hb[i] * w1[i * 64 + lane];
        float f = sin_rad(fq[lane] * acc);
        LDS_WAIT(); __builtin_amdgcn_wave_barrier();
        hb[64 + lane] = f;
        LDS_WAIT(); __builtin_amdgcn_wave_barrier();
        acc = b2[lane];
#pragma unroll 16
        for (int i = 0; i < 64; ++i) acc += hb[64 + i] * w2[i * 64 + lane];
        f = sin_rad(fq[64 + lane] * acc);
        LDS_WAIT(); __builtin_amdgcn_wave_barrier();
        hb[lane] = f;
        LDS_WAIT(); __builtin_amdgcn_wave_barrier();
        acc = b3[lane];
#pragma unroll 16
        for (int i = 0; i < 64; ++i) acc += hb[i] * w3[i * 64 + lane];
        f = sin_rad(fq[128 + lane] * acc);
        ((float*)(F.ws + WS_HID))[((size_t)set * SEQ + t) * 64 + lane] = f;
        LDS_WAIT(); __builtin_amdgcn_wave_barrier();
    }
}

__device__ __forceinline__ void p0_filter_td(const Frame& F) {
    constexpr int NI0 = (SEQ / 512) * 32;
    for (int it = F.bid; it < 2 * NI0 + 32; it += F.G) {
        int set, tb, cg; if (it < 2 * NI0) { set = it / NI0; const int r = it % NI0; tb = r >> 5; cg = r & 31; } else { set = 2; tb = 0; cg = it - 2 * NI0; }
        const int hj = (set == 1) ? 1 : 0, L = (set == 2) ? CTX : SEQ, t = tb * 512 + F.tid; const bool valid = t < L;
        const CAS float* w4 = (const CAS float*)(IN(I_FW4) + (size_t)hj * 64 * 2 * D);
        const float* hrow = (const float*)(F.ws + WS_HID) + ((size_t)set * SEQ + (valid ? t : 0)) * 64;
        float hreg[64];
#pragma unroll
        for (int j = 0; j < 16; ++j) { const f32x4 v = *(const f32x4*)(hrow + 4 * j); hreg[4 * j] = v[0]; hreg[4 * j + 1] = v[1]; hreg[4 * j + 2] = v[2]; hreg[4 * j + 3] = v[3]; }
        const float tn = (float)t / (float)(L - 1);
        float* outb = (set == 2) ? (float*)(F.ws + WS_FILTC) : (float*)(F.ws + WS_FILT + (size_t)set * 256 * MiB);
        const int L2 = 2 * L;
        for (int ch = 0; ch < 4; ++ch) {
            const int c0 = cg * 64 + ch * 16;
            float fa[16], ba[16];
#pragma unroll
            for (int e = 0; e < 16; ++e) { fa[e] = 0.f; ba[e] = 0.f; }
#pragma unroll
            for (int j = 0; j < 64; ++j) {
#pragma unroll
                for (int e = 0; e < 16; ++e) { fa[e] += hreg[j] * w4[j * (2 * D) + c0 + e]; ba[e] += hreg[j] * w4[j * (2 * D) + D + c0 + e]; }
            }
            if (valid) {
#pragma unroll
                for (int e = 0; e < 16; ++e) { const int c = c0 + e;
                    const float lin = -3.0701134573253943f + (float)c * ((-15.350567286626972f + 3.0701134573253943f) / (float)(D - 1));
                    const float dec = __builtin_amdgcn_exp2f(-1.4426950408889634f * tn * fabsf(lin));
                    float* orow = outb + (size_t)c * L2;
                    orow[t] = fa[e] * dec;
                    if (t == 0) orow[L] = 0.f; else orow[L2 - t] = ba[e] * dec; }
            }
        }
    }
}

__device__ __forceinline__ void p0_filter_fft(const Frame& F) {
    using namespace fftc;
    LAS cf* X = (LAS cf*)F.lds;
    for (int it = F.bid; it < 2 * D; it += F.G) {
        float* row = (float*)(F.ws + WS_FILT) + (size_t)it * (2 * SEQ);
        for (int n = F.tid; n < FM; n += NTHR) { const f32x2 v = *(const f32x2*)(row + 2 * n); X[phys(n)] = v; }
        __syncthreads();
        fft_forward(X, F.tid);
        const float sc = 1.0f / (float)FM;
        for (int q = F.tid; q < FM / 2; q += NTHR) {
            f32x4 o;
            if (q == 0) { const cf Z0 = X[phys(0)], Zh = X[phys(1)]; o = (f32x4){(Z0.x + Z0.y) * sc, Zh.x * sc, (Z0.x - Z0.y) * sc, -Zh.y * sc}; }
            else { int p, p2, k; pair_pos(q, p, p2, k); cf Xk, Xmk; real_unpack(X[phys(p)], X[phys(p2)], k, Xk, Xmk); o = (f32x4){Xk.x * sc, Xk.y * sc, Xmk.x * sc, Xmk.y * sc}; }
            *(f32x4*)(row + 4 * q) = o;
        }
        __syncthreads();
    }
}

__device__ __forceinline__ void thin_phase(const Frame& F, int ph) {
    LAS float* cA = (LAS float*)F.lds;
    LAS float* cAc = cA + D; LAS float* cB = cA + 2 * D; LAS float* cBc = cA + 3 * D; LAS float* cC = cA + 4 * D; LAS float* cCc = cA + 5 * D;
    const float* mod = (const float*)(F.ws + WS_MOD); const float* modc = (const float*)(F.ws + WS_MOD + 512 * 1024);
    const int l = ph / 3, k = ph % 3, pl = (ph - 1) / 3, pk = (ph - 1) % 3;
    const bool has_prev = ph >= 1, has_next = ph < 12, ctx_rows = ph <= 4;
    const float* npost = IN(I_NPOST); const float* npre = IN(I_NPRE); const float* xin = IN(I_X); const float* cin = IN(I_CTX); float* outp = OUTP;
    for (int i = F.tid; i < D; i += NTHR) {
        if (has_prev) { const float wgt = (pk == 1) ? 1.0f : 0.5f, gp = npost[(pl * 3 + pk) * D + i];
            cA[i] = wgt * gp * mod[pl * (NMOD * D) + (3 * pk + 2) * D + i];
            if (ctx_rows) cAc[i] = wgt * gp * modc[pl * (NMOD * D) + (3 * pk + 2) * D + i]; }
        if (has_next) { const float g = npre[(l * 3 + k) * D + i];
            cB[i] = g * (1.0f + mod[l * (NMOD * D) + (3 * k + 1) * D + i]); cC[i] = mod[l * (NMOD * D) + (3 * k) * D + i];
            if (ctx_rows) { cBc[i] = g * (1.0f + modc[l * (NMOD * D) + (3 * k + 1) * D + i]); cCc[i] = modc[l * (NMOD * D) + (3 * k) * D + i]; } }
    }
    __syncthreads();
    const int nrows = ctx_rows ? MT : SEQ;
    float* H = (float*)(F.ws + WS_H); const float* Y = (const float*)(F.ws + WS_Y); bf16_t* U = (bf16_t*)(F.ws + WS_U);
    for (int row = F.bid * NWAVES + F.wave; row < nrows; row += F.G * NWAVES) {
        const bool isc = row >= SEQ;
        const float* hsrc = (ph == 0) ? (isc ? cin + (size_t)(row - SEQ) * D : xin + (size_t)row * D) : H + (size_t)row * D;
        f32x4 h[8];
#pragma unroll
        for (int j = 0; j < 8; ++j) h[j] = *(const f32x4*)(hsrc + 4 * (F.lane + 64 * j));
        if (has_prev) {
            f32x4 y[8]; float ss = 0.f;
#pragma unroll
            for (int j = 0; j < 8; ++j) { y[j] = *(const f32x4*)(Y + (size_t)row * D + 4 * (F.lane + 64 * j)); ss += (y[j][0] * y[j][0] + y[j][1] * y[j][1]) + (y[j][2] * y[j][2] + y[j][3] * y[j][3]); }
            const float rstd = 1.0f / sqrtf(wave_sum(ss) * (1.0f / D) + NORM_EPS);
            const LAS float* ca = isc ? cAc : cA;
#pragma unroll
            for (int j = 0; j < 8; ++j) { const f32x4 cv = *(const LAS f32x4*)(ca + 4 * (F.lane + 64 * j)); h[j] += cv * (y[j] * rstd); }
        }
        if (!has_next) {
#pragma unroll
            for (int j = 0; j < 8; ++j) *(f32x4*)(outp + (size_t)row * D + 4 * (F.lane + 64 * j)) = h[j];
            continue;
        }
        float ss2 = 0.f;
#pragma unroll
        for (int j = 0; j < 8; ++j) { *(f32x4*)(H + (size_t)row * D + 4 * (F.lane + 64 * j)) = h[j]; ss2 += (h[j][0] * h[j][0] + h[j][1] * h[j][1]) + (h[j][2] * h[j][2] + h[j][3] * h[j][3]); }
        const float rstd2 = 1.0f / sqrtf(wave_sum(ss2) * (1.0f / D) + NORM_EPS);
        const LAS float* cb = isc ? cBc : cB; const LAS float* cc = isc ? cCc : cC;
#pragma unroll
        for (int j = 0; j < 8; ++j) { const f32x4 bv = *(const LAS f32x4*)(cb + 4 * (F.lane + 64 * j)), cv = *(const LAS f32x4*)(cc + 4 * (F.lane + 64 * j));
            const f32x4 u = (h[j] * rstd2) * bv + cv; u32x2 w; w.x = cvt_pk_bf16(u[0], u[1]); w.y = cvt_pk_bf16(u[2], u[3]);
            *(u32x2*)(U + (size_t)row * D + 4 * (F.lane + 64 * j)) = w; }
    }
    __syncthreads();
}

__device__ __forceinline__ void sc_pair(const bf16_t* row, int t0, int len, float w0, float w1, float w2, float b, float& o0, float& o1) {
    const unsigned pr = *(const unsigned*)(row + t0); const float x0 = bflo(pr), x1 = bfhi(pr);
    const float xm = (t0 > 0) ? bf2f(row[t0 - 1]) : 0.f, xp = (t0 + 2 < len) ? bf2f(row[t0 + 2]) : 0.f;
    o0 = xm * w0 + x0 * w1 + x1 * w2 + b; o1 = x0 * w0 + x1 * w1 + xp * w2 + b;
}
__device__ __forceinline__ void hyena_conv_phase(const Frame& F, int hj, int set, bool with_ctx) {
    using namespace fftc;
    LAS cf* X = (LAS cf*)F.lds;
    const bf16_t* ZT = (const bf16_t*)(F.ws + WS_ZT); bf16_t* GT = (bf16_t*)(F.ws + WS_GT);
    const float* wsc = IN(I_HWSC) + (size_t)hj * 3 * (3 * D); const float* bsc = IN(I_HBSC) + (size_t)hj * (3 * D); const float* skp = IN(I_HSKIP);
    for (int c = F.bid; c < D; c += F.G) {
        const bf16_t* r0 = ZT + (size_t)c * MT; const bf16_t* r1 = ZT + (size_t)(D + c) * MT; const bf16_t* r2 = ZT + (size_t)(2 * D + c) * MT;
        const float a0 = wsc[c], a1 = wsc[3 * D + c], a2 = wsc[6 * D + c], ab = bsc[c];
        const float b0 = wsc[D + c], b1 = wsc[3 * D + D + c], b2 = wsc[6 * D + D + c], bb = bsc[D + c];
        const float v0 = wsc[2 * D + c], v1 = wsc[3 * D + 2 * D + c], v2 = wsc[6 * D + 2 * D + c], vb = bsc[2 * D + c];
        const float skip = skp[hj * D + c];
        for (int n = F.tid; n < FM; n += NTHR) {
            cf z = (cf){0.f, 0.f};
            if (n < SEQ / 2) { float p0, p1, q0, q1; sc_pair(r1, 2 * n, SEQ, b0, b1, b2, bb, p0, p1); sc_pair(r2, 2 * n, SEQ, v0, v1, v2, vb, q0, q1); z = (cf){p0 * q0, p1 * q1}; }
            X[phys(n)] = z;
        }
        __syncthreads();
        fft_forward(X, F.tid);
        const f32x4* Fp = (const f32x4*)((const float*)(F.ws + WS_FILT) + ((size_t)set * D + c) * (2 * SEQ));
        for (int q = F.tid; q < FM / 2; q += NTHR) {
            const f32x4 f = Fp[q];
            if (q == 0) {
                const cf Z0 = X[phys(0)], Zh = X[phys(1)];
                const float Y0 = (Z0.x + Z0.y) * f[0], YM = (Z0.x - Z0.y) * f[2];
                X[phys(0)] = (cf){0.5f * (Y0 + YM), 0.5f * (Y0 - YM)};
                const cf Yh = cmul(cconj(Zh), (cf){f[1], f[3]}); X[phys(1)] = cconj(Yh);
            } else {
                int p, p2, k; pair_pos(q, p, p2, k); cf Xk, Xmk; real_unpack(X[phys(p)], X[phys(p2)], k, Xk, Xmk);
                const cf Yk = cmul(Xk, (cf){f[0], f[1]}), Ymk = cmul(Xmk, (cf){f[2], f[3]});
                cf Zk, Zk2; real_pack(Yk, Ymk, k, Zk, Zk2); X[phys(p)] = Zk; X[phys(p2)] = Zk2;
            }
        }
        __syncthreads();
        fft_inverse(X, F.tid);
        for (int n = F.tid; n < SEQ / 2; n += NTHR) {
            const cf y = X[phys(n)];
            float p0, p1, q0, q1, x0a, x0b; sc_pair(r1, 2 * n, SEQ, b0, b1, b2, bb, p0, p1); sc_pair(r2, 2 * n, SEQ, v0, v1, v2, vb, q0, q1); sc_pair(r0, 2 * n, SEQ, a0, a1, a2, ab, x0a, x0b);
            const float g0 = x0a * (y.x + p0 * q0 * skip), g1 = x0b * (y.y + p1 * q1 * skip);
            *(unsigned*)(GT + (size_t)c * MT + 2 * n) = cvt_pk_bf16(g0, g1);
        }
        __syncthreads();
        if (with_ctx) {
            LAS float* wb = (LAS float*)F.lds; LAS float* fb = wb + CTX;
            const float* fc = (const float*)(F.ws + WS_FILTC) + (size_t)c * (2 * CTX);
            float x0c = 0.f, wv = 0.f;
            if (F.tid < CTX / 2) {
                const int n = F.tid; float p0, p1, q0, q1;
                sc_pair(r1 + SEQ, 2 * n, CTX, b0, b1, b2, bb, p0, p1); sc_pair(r2 + SEQ, 2 * n, CTX, v0, v1, v2, vb, q0, q1);
                wb[2 * n] = p0 * q0; wb[2 * n + 1] = p1 * q1;
            }
            fb[F.tid] = fc[F.tid];
            __syncthreads();
            if (F.tid < CTX) {
                const int t = F.tid; float acc = 0.f;
                for (int s = 0; s < CTX; ++s) acc += fb[(t - s) & (2 * CTX - 1)] * wb[s];
                wv = wb[t];
                const int te = t & ~1; float xa, xb; sc_pair(r0 + SEQ, te, CTX, a0, a1, a2, ab, xa, xb); x0c = (t & 1) ? xb : xa;
                GT[(size_t)c * MT + SEQ + t] = f2bf(x0c * (acc + wv * skip));
            }
            __syncthreads();
        }
    }
}

__device__ __forceinline__ void transpose_phase(const Frame& F, int nrows) {
    LAS bf16_t* tile = (LAS bf16_t*)(F.lds + F.wave * 8704);
    const bf16_t* GT = (const bf16_t*)(F.ws + WS_GT); bf16_t* U = (bf16_t*)(F.ws + WS_U);
    const int ntt = nrows / 64, ntiles = (D / 64) * ntt;
    for (int it = F.bid * NWAVES + F.wave; it < ntiles; it += F.G * NWAVES) {
        const int ct = it / ntt, tt = it % ntt, c0 = ct * 64, t0 = tt * 64;
#pragma unroll 4
        for (int i = 0; i < 16; ++i) { const int r = 4 * i + (F.lane >> 4), cc = (F.lane & 15) * 4;
            const u32x2 v = *(const u32x2*)(GT + (size_t)(c0 + r) * MT + t0 + cc);
            tile[r * 66 + cc] = (bf16_t)(v.x & 0xffff); tile[r * 66 + cc + 1] = (bf16_t)(v.x >> 16); tile[r * 66 + cc + 2] = (bf16_t)(v.y & 0xffff); tile[r * 66 + cc + 3] = (bf16_t)(v.y >> 16); }
        LDS_WAIT(); __builtin_amdgcn_wave_barrier();
#pragma unroll 4
        for (int i = 0; i < 16; ++i) { const int t = 4 * i + (F.lane >> 4), cc = (F.lane & 15) * 4;
            const unsigned e0 = tile[(cc + 0) * 66 + t], e1 = tile[(cc + 1) * 66 + t], e2 = tile[(cc + 2) * 66 + t], e3 = tile[(cc + 3) * 66 + t];
            u32x2 w; w.x = e0 | (e1 << 16); w.y = e2 | (e3 << 16);
            *(u32x2*)(U + (size_t)(t0 + t) * D + c0 + cc) = w; }
        LDS_WAIT(); __builtin_amdgcn_wave_barrier();
    }
}

__device__ __forceinline__ void rope_phase(const Frame& F) {
    bf16_t* QKV = (bf16_t*)(F.ws + WS_ZT); const f32x2* tab = (const f32x2*)(F.ws + WS_ROPE);
    for (int idx = F.bid * NTHR + F.tid; idx < SEQ * 160; idx += F.G * NTHR) {
        const int t = idx / 160, r = idx % 160, head = r >> 3, half = (r >> 2) & 1, ch = r & 3;
        const int col = (head < 16 ? head * 128 : 2048 + (head - 16) * 128) + half * 64 + ch * 8;
        bf16_t* p1 = QKV + (size_t)t * QKVD + col; bf16_t* p2 = p1 + 32;
        const int pos = half == 0 ? (t >> 6) : (t & 63);
        const f32x4* tb = (const f32x4*)(tab + pos * 32 + ch * 8);
        const u32x4 v1 = *(const u32x4*)p1, v2 = *(const u32x4*)p2; u32x4 o1, o2;
#pragma unroll
        for (int e = 0; e < 4; ++e) { const f32x4 cs = tb[e];
            const float a0 = bflo(v1[e]), a1 = bfhi(v1[e]), b0 = bflo(v2[e]), b1 = bfhi(v2[e]);
            o1[e] = cvt_pk_bf16(a0 * cs[0] - b0 * cs[1], a1 * cs[2] - b1 * cs[3]);
            o2[e] = cvt_pk_bf16(b0 * cs[0] + a0 * cs[1], b1 * cs[2] + a1 * cs[3]); }
        *(u32x4*)p1 = o1; *(u32x4*)p2 = o2;
    }
}

typedef short s16x4 __attribute__((ext_vector_type(4)));
__device__ __forceinline__ void attn_phase(const Frame& F) {
    constexpr int KP = 288;
    LAS unsigned char* Ks = F.lds; LAS unsigned char* Vs = F.lds + 64 * KP;
    const bf16_t* QKV = (const bf16_t*)(F.ws + WS_ZT); bf16_t* O = (bf16_t*)(F.ws + WS_U);
    const int fr = F.lane & 15, fq = F.lane >> 4; const float* sinkp = IN(I_ASINK);
    for (int unit = F.bid; unit < (SEQ / 128) * 16; unit += F.G) {
        const int qb = unit >> 4, h = unit & 15, kvh = h >> 2, q0 = qb * 128 + 16 * F.wave;
        bf16x8 Qf[4];
#pragma unroll
        for (int ks = 0; ks < 4; ++ks) Qf[ks] = *(const bf16x8*)(QKV + (size_t)(q0 + fr) * QKVD + h * 128 + 32 * ks + 8 * fq);
        float m = sinkp[h] * 1.4426950408889634f;
        float lpart = (fq == 0) ? 1.0f : 0.0f;
        f32x4 Oacc[8];
#pragma unroll
        for (int dt = 0; dt < 8; ++dt) Oacc[dt] = (f32x4){0.f, 0.f, 0.f, 0.f};
        for (int ti = 0; ti < 10; ++ti) {
            const bool is_ctx = ti >= 6;
            const int krow0 = is_ctx ? SEQ + 64 * (ti - 6) : (qb - 1) * 128 + 64 * ti;
            if (!is_ctx && (krow0 < 0 || krow0 >= SEQ)) continue;
            __syncthreads();
            { const int r = F.tid >> 4, ch = F.tid & 15;
#pragma unroll
                for (int hh = 0; hh < 2; ++hh) { const int rr = r + 32 * hh; const bf16_t* src = QKV + (size_t)(krow0 + rr) * QKVD + kvh * 128 + ch * 8;
                    const u32x4 kv = *(const u32x4*)(src + 2048), vv = *(const u32x4*)(src + 2560);
                    *(LAS u32x4*)(Ks + rr * KP + ch * 16) = kv; *(LAS u32x4*)(Vs + rr * KP + ch * 16) = vv; } }
            __syncthreads();
            const bool active = is_ctx || !(krow0 + 63 < q0 - 128 || krow0 > q0 + 15 + 128);
            if (active) {
                f32x4 st[4];
#pragma unroll
                for (int kt = 0; kt < 4; ++kt) { st[kt] = (f32x4){0.f, 0.f, 0.f, 0.f};
#pragma unroll
                    for (int ks = 0; ks < 4; ++ks) { const bf16x8 kf = *(const LAS bf16x8*)(Ks + (16 * kt + fr) * KP + (32 * ks + 8 * fq) * 2);
                        st[kt] = __builtin_amdgcn_mfma_f32_16x16x32_bf16(kf, Qf[ks], st[kt], 0, 0, 0); } }
                const float cs = 0.08838834764831845f * 1.4426950408889634f;
                float tmax = -INFINITY;
#pragma unroll
                for (int kt = 0; kt < 4; ++kt)
#pragma unroll
                    for (int r = 0; r < 4; ++r) { float v = st[kt][r] * cs;
                        if (!is_ctx) { const int dk = (krow0 + 16 * kt + 4 * fq + r) - (q0 + fr); if (dk > 128 || dk < -128) v = -INFINITY; }
                        st[kt][r] = v; tmax = fmaxf(tmax, v); }
                tmax = fmaxf(tmax, __shfl_xor(tmax, 16)); tmax = fmaxf(tmax, __shfl_xor(tmax, 32));
                const float mn = fmaxf(m, tmax), alpha = __builtin_amdgcn_exp2f(m - mn); m = mn;
                lpart *= alpha;
#pragma unroll
                for (int dt = 0; dt < 8; ++dt) Oacc[dt] *= alpha;
                bf16x8 pf[2];
#pragma unroll
                for (int kk = 0; kk < 2; ++kk) { float p[8];
#pragma unroll
                    for (int j = 0; j < 8; ++j) { p[j] = __builtin_amdgcn_exp2f(st[2 * kk + (j >> 2)][j & 3] - m); lpart += p[j]; }
                    u32x4 w; w.x = cvt_pk_bf16(p[0], p[1]); w.y = cvt_pk_bf16(p[2], p[3]); w.z = cvt_pk_bf16(p[4], p[5]); w.w = cvt_pk_bf16(p[6], p[7]);
                    pf[kk] = __builtin_bit_cast(bf16x8, w); }
#pragma unroll
                for (int kk = 0; kk < 2; ++kk)
#pragma unroll
                    for (int dt = 0; dt < 8; ++dt) {
                        LAS unsigned char* ap = Vs + (32 * kk + 4 * fq + (fr >> 2)) * KP + (16 * dt + 4 * (fr & 3)) * 2;
                        const s16x4 lo = __builtin_amdgcn_ds_read_tr16_b64_v4i16((LAS s16x4*)ap), hi = __builtin_amdgcn_ds_read_tr16_b64_v4i16((LAS s16x4*)(ap + 16 * KP));
                        const bf16x8 vf = {lo[0], lo[1], lo[2], lo[3], hi[0], hi[1], hi[2], hi[3]};
                        Oacc[dt] = __builtin_amdgcn_mfma_f32_16x16x32_bf16(vf, pf[kk], Oacc[dt], 0, 0, 0);
                    }
            }
        }
        float lsum = lpart; lsum += __shfl_xor(lsum, 16); lsum += __shfl_xor(lsum, 32);
        const float inv = 1.0f / lsum;
#pragma unroll
        for (int dt = 0; dt < 8; ++dt) { const f32x4 o = Oacc[dt] * inv; u32x2 w; w.x = cvt_pk_bf16(o[0], o[1]); w.y = cvt_pk_bf16(o[2], o[3]);
            *(u32x2*)(O + (size_t)(q0 + fr) * D + h * 128 + 16 * dt + 4 * fq) = w; }
    }
    __syncthreads();
}

__device__ __forceinline__ void pool_phase(const Frame& F) {
    const bf16_t* U = (const bf16_t*)(F.ws + WS_U); bf16_t* P = (bf16_t*)(F.ws + WS_GT);
    for (int idx = F.bid * NTHR + F.tid; idx < SEQ * (D / 8); idx += F.G * NTHR) {
        const int t = idx >> 8, col = (idx & 255) * 8, g = col >> 9, size = 2 << g;
        int lo = t - size / 2, hi = lo + size; lo = lo < 0 ? 0 : lo; hi = hi > SEQ ? SEQ : hi;
        float s[8];
#pragma unroll
        for (int e = 0; e < 8; ++e) s[e] = 0.f;
        for (int r = lo; r < hi; ++r) { const u32x4 v = *(const u32x4*)(U + (size_t)r * D + col);
#pragma unroll
            for (int e = 0; e < 4; ++e) { s[2 * e] += bflo(v[e]); s[2 * e + 1] += bfhi(v[e]); } }
        const u32x4 cv = *(const u32x4*)(U + (size_t)t * D + col); const float invn = 1.0f / (float)(hi - lo);
        u32x4 o;
#pragma unroll
        for (int e = 0; e < 4; ++e) o[e] = cvt_pk_bf16(s[2 * e] * invn - bflo(cv[e]), s[2 * e + 1] * invn - bfhi(cv[e]));
        *(u32x4*)(P + (size_t)t * D + col) = o;
    }
}

__global__ void __launch_bounds__(NTHR, 2) fwd_kernel(Args a_unused) {
    (void)a_unused;
    {
        Frame F = mk_frame();
        volatile LAS unsigned* MISC = (volatile LAS unsigned*)(F.lds + MISC_OFF);
        for (int u = F.tid; u < (LDS_BYTES - MISC_OFF) / 4; u += NTHR) MISC[u] = 0u;
        __syncthreads();
    }
    XcdBarrier bar;
    { Frame F = mk_frame(); bar = xcd_barrier_post((unsigned*)(F.ws + WS_CTL) + CW_BAR, (volatile LAS unsigned*)(F.lds + MISC_OFF) + 8); }
#define GRID_BAR() xcd_barrier(bar)

    { Frame F = mk_frame(); p0_convert(F); __syncthreads(); }
    { Frame F = mk_frame(); p0_mods(F); }
    { Frame F = mk_frame(); p0_rope(F); }
    { Frame F = mk_frame(); p0_hidden(F); }
    GRID_BAR();
    { Frame F = mk_frame(); p0_filter_td(F); }
    GRID_BAR();
    { Frame F = mk_frame(); p0_filter_fft(F); __syncthreads(); }

    for (int ph = 0; ph < 12; ++ph) {
        { Frame F = mk_frame(); thin_phase(F, ph); }
        GRID_BAR();
        const int l = ph / 3, k = ph % 3, kind = l % 3, mj = l / 3;
        const int Mx = (ph <= 4) ? MT : SEQ;
        if (k != 1) {
            const int fi = l * 2 + (k >> 1);
            { Frame F = mk_frame();
              pg8::Gemm g{(const bf16_t*)(F.ws + WS_U), (const bf16_t*)(F.ws + WS_WIN) + (size_t)fi * 2 * DFF * D, Mx, 2 * DFF, D, D, D, 0, 0};
              pg8::StaticOrder S; S.init(g.M, g.N, F.G, F.bid);
              pg8::EpiSwiGLU E{(bf16_t*)(F.ws + WS_ACT), DFF};
              pg8::gemm_phase<pg8::EpiSwiGLU>(F.lds, g, S, E); }
            GRID_BAR();
        } else {
            if (kind != 2) {
                Frame F = mk_frame();
                pg8::Gemm g; pg8::EpiBf16 E;
                if (kind == 0) { g = pg8::Gemm{(const bf16_t*)(F.ws + WS_WHIN) + (size_t)mj * 3 * D * D, (const bf16_t*)(F.ws + WS_U), 3 * D, Mx, D, D, D, 0, 0};
                    E = pg8::EpiBf16{(bf16_t*)(F.ws + WS_ZT), MT, nullptr, IN(I_HBIN) + (size_t)mj * 3 * D}; }
                else { g = pg8::Gemm{(const bf16_t*)(F.ws + WS_U), (const bf16_t*)(F.ws + WS_WQKV), Mx, QKVD, D, D, D, 0, 0};
                    E = pg8::EpiBf16{(bf16_t*)(F.ws + WS_ZT), QKVD, IN(I_ABQKV), nullptr}; }
                pg8::StaticOrder S; S.init(g.M, g.N, F.G, F.bid);
                pg8::gemm_phase<pg8::EpiBf16>(F.lds, g, S, E);
            }
            if (kind != 2) GRID_BAR();
            if (kind == 0) {
                { Frame F = mk_frame(); hyena_conv_phase(F, mj, mj, ph == 1); }
                GRID_BAR();
                { Frame F = mk_frame(); transpose_phase(F, Mx); }
                GRID_BAR();
            } else if (kind == 1) {
                { Frame F = mk_frame(); rope_phase(F); }
                GRID_BAR();
                { Frame F = mk_frame(); attn_phase(F); }
                GRID_BAR();
            } else {
                { Frame F = mk_frame(); pool_phase(F); }
                GRID_BAR();
            }
        }
        { Frame F = mk_frame();
          pg8::Gemm gF; pg8::EpiF32 eF;
          if (k != 1) { const int fi = l * 2 + (k >> 1);
              gF = pg8::Gemm{(const bf16_t*)(F.ws + WS_ACT), (const bf16_t*)(F.ws + WS_WOUT) + (size_t)fi * D * DFF, Mx, D, DFF, DFF, DFF, 0, 0};
              eF = pg8::EpiF32{(float*)(F.ws + WS_Y), D, nullptr, nullptr}; }
          else if (kind == 0) { gF = pg8::Gemm{(const bf16_t*)(F.ws + WS_U), (const bf16_t*)(F.ws + WS_WHOUT) + (size_t)mj * D * D, Mx, D, D, D, D, 0, 0};
              eF = pg8::EpiF32{(float*)(F.ws + WS_Y), D, IN(I_HBOUT) + (size_t)mj * D, nullptr}; }
          else if (kind == 1) { gF = pg8::Gemm{(const bf16_t*)(F.ws + WS_U), (const bf16_t*)(F.ws + WS_WO), SEQ, D, D, D, D, 0, 0};
              eF = pg8::EpiF32{(float*)(F.ws + WS_Y), D, IN(I_ABO), nullptr}; }
          else { gF = pg8::Gemm{(const bf16_t*)(F.ws + WS_GT), (const bf16_t*)(F.ws + WS_WP), SEQ, D, 512, D, 512, 1, 512};
              eF = pg8::EpiF32{(float*)(F.ws + WS_Y), D, IN(I_PB), IN(I_PSCALE)}; }
          pg8::StaticOrder S; S.init(gF.M, gF.N, F.G, F.bid);
          pg8::gemm_phase<pg8::EpiF32>(F.lds, gF, S, eF); }
        GRID_BAR();
    }
    { Frame F = mk_frame(); thin_phase(F, 12); }
}

static_assert(offsetof(Args, out) == 8 * 33 && offsetof(Args, ws) == 8 * 34 && offsetof(Args, invf) == 8 * 35 && sizeof(Args) == 8 * 67, "kernarg layout");
extern "C" void kernel_launch(void* const* d_in, const int* in_sizes, int n_in, void* d_out, int out_size, void* d_ws, size_t ws_size, hipStream_t stream) {
    static int grid = 0;
    if (grid == 0) {
        if (n_in != 33 || out_size != SEQ * D || ws_size < WS_END) { fprintf(stderr, "kernel_launch: unexpected problem: n_in %d out %d ws %zu (need %zu)\n", n_in, out_size, ws_size, (size_t)WS_END); grid = -1; return; }
        int dev = 0, cus = 0, per_cu = 0;
        if (hipGetDevice(&dev) != hipSuccess || hipDeviceGetAttribute(&cus, hipDeviceAttributeMultiprocessorCount, dev) != hipSuccess) { grid = -1; return; }
        if (hipFuncSetAttribute((const void*)fwd_kernel, hipFuncAttributeMaxDynamicSharedMemorySize, LDS_BYTES) != hipSuccess) { fprintf(stderr, "kernel_launch: hipFuncSetAttribute failed\n"); grid = -1; return; }
        if (hipOccupancyMaxActiveBlocksPerMultiprocessor(&per_cu, (const void*)fwd_kernel, NTHR, LDS_BYTES) != hipSuccess || per_cu < 1) fprintf(stderr, "kernel_launch: occupancy query says %d\n", per_cu);
        (void)hipGetLastError();
        grid = cus;
    }
    if (grid < 0) return;
    (void)in_sizes;
    if (hipMemsetAsync((char*)d_ws + WS_CTL, 0, CTL_ZERO_BYTES, stream) != hipSuccess) { fprintf(stderr, "kernel_launch: memset failed\n"); return; }
    Args a{};
    for (int i = 0; i < 33; ++i) a.in[i] = (const float*)d_in[i];
    a.out = (float*)d_out; a.ws = (unsigned char*)d_ws;
    for (int j = 0; j < 32; ++j) a.invf[j] = std::pow(10000.0, -(double)j / 32.0);
    hipLaunchKernelGGL(fwd_kernel, dim3(grid), dim3(NTHR), LDS_BYTES, stream, a);
    const hipError_t le = hipPeekAtLastError();
    if (le != hipSuccess) fprintf(stderr, "kernel_launch: launch failed: %s\n", hipGetErrorName(le));
}
```

```cpp
#include <hip/hip_runtime.h>
#include <cstdio>
#include <cstdint>
#include <cmath>
#include <cstddef>

#define LAS __attribute__((address_space(3)))
#define GAS __attribute__((address_space(1)))
#define CAS __attribute__((address_space(4)))
typedef unsigned short bf16_t;
typedef short bf16x8 __attribute__((ext_vector_type(8)));
typedef float f32x4 __attribute__((ext_vector_type(4)));
typedef float f32x2 __attribute__((ext_vector_type(2)));
typedef unsigned u32x4 __attribute__((ext_vector_type(4)));
typedef unsigned u32x2 __attribute__((ext_vector_type(2)));
typedef _Float16 f16x4 __attribute__((ext_vector_type(4)));

constexpr int D = 2048, SEQ = 16384, CTX = 256, MT = SEQ + CTX, DEPTH = 4, DFF = 5632, NMOD = 9, QKVD = 3072;
constexpr int DFFP = DFF + 64;
constexpr int NWAVES = 8, NTHR = 512;
constexpr float NORM_EPS = 1e-6f;

constexpr size_t MiB = 1u << 20;
constexpr size_t WS_CTL = 0, CTL_ZERO_BYTES = 1 * MiB;
constexpr size_t WS_MOD = 1 * MiB;
constexpr size_t WS_ROPE = 2 * MiB;
constexpr size_t WS_HID = 3 * MiB;
constexpr size_t WS_FILTC = 15 * MiB;
constexpr size_t WS_FILT = 19 * MiB;
constexpr size_t WS_WIN = WS_FILT + 512 * MiB;
constexpr size_t WS_WOUT = WS_WIN + 352 * MiB;
constexpr size_t WOUT_STRIDE = 23 * MiB / 2;
constexpr size_t WS_WHIN = WS_WOUT + 184 * MiB;
constexpr size_t WS_WHOUT = WS_WHIN + 48 * MiB;
constexpr size_t WS_WQKV = WS_WHOUT + 16 * MiB;
constexpr size_t WS_WO = WS_WQKV + 12 * MiB;
constexpr size_t WS_WP = WS_WO + 8 * MiB;
constexpr size_t WS_H = WS_WP + 2 * MiB;
constexpr size_t WS_U = WS_H + 130 * MiB;
constexpr size_t WS_ACT = WS_U + 65 * MiB;
constexpr size_t WS_Y = WS_ACT + 182 * MiB;
constexpr size_t WS_ZT = WS_Y + 130 * MiB;
constexpr size_t WS_GT = WS_ZT + 195 * MiB;
constexpr size_t WS_P = WS_GT + 65 * MiB;
constexpr size_t WS_END = WS_P + 12 * MiB;
constexpr size_t WS_KVC = WS_ROPE + 131072;
constexpr size_t WS_BQP = WS_ROPE + 65536;
constexpr int CW_TMO = 0;
constexpr int CW_BAR = 4096;
constexpr int CW_LBAR = 3072;
constexpr int CW_SUBBAR = 2048;
constexpr int CW_XRANK = 1024;

constexpr int LDS_SCRATCH = 143360;
constexpr int MISC_OFF = LDS_SCRATCH;
constexpr int LDS_BYTES = 151552;

__device__ __forceinline__ unsigned cvt_pk_bf16(float lo, float hi) { unsigned r; asm volatile("v_cvt_pk_bf16_f32 %0, %1, %2" : "=v"(r) : "v"(lo), "v"(hi)); return r; }
__device__ __forceinline__ float bf2f(unsigned short b) { return __uint_as_float(((unsigned)b) << 16); }
__device__ __forceinline__ float bflo(unsigned w) { return __uint_as_float(w << 16); }
__device__ __forceinline__ float bfhi(unsigned w) { return __uint_as_float(w & 0xffff0000u); }
__device__ __forceinline__ bf16_t f2bf(float f) { return (bf16_t)(cvt_pk_bf16(f, 0.f) & 0xffffu); }
__device__ __forceinline__ float wave_sum(float v) {
#pragma unroll
    for (int o = 1; o < 64; o <<= 1) v += __shfl_xor(v, o);
    return v;
}
__device__ __forceinline__ float silu_f(float x) { return x * __builtin_amdgcn_rcpf(1.f + __builtin_amdgcn_exp2f(-1.4426950408889634f * x)); }
#define LDS_WAIT() asm volatile("s_waitcnt lgkmcnt(0)" ::: "memory")
#define VM_WAIT() asm volatile("s_waitcnt vmcnt(0)" ::: "memory")

#if defined(DIAG_MASK) && defined(DIAG_GEMM)
__device__ __forceinline__ void diag_stamp(int cls);
#define GSTAMP(c) do { if ((c) >= 0) diag_stamp(c); } while (0)
#else
#define GSTAMP(c) do { } while (0)
#endif
namespace pg8 {
constexpr int BM = 256, BK = 64, HALF = 128, HTB = HALF * BK * 2, STAGE_BYTES = 8 * HTB, NXCD = 8, WGM = 8;
__host__ __device__ __forceinline__ int lds_byte(int r, int c) { const int st = (r >> 4) * 2 + (c >> 5), rr = r & 15, cc = c & 31, ob = rr * 64 + cc * 2; return st * 1024 + (ob ^ (((ob >> 9) & 1) << 5)); }
__host__ __device__ __forceinline__ void stage_rc(int b, int& R, int& C) { const int st = b / 1024, sb = b % 1024, swz = sb ^ (((sb >> 9) & 1) << 5); R = (st >> 1) * 16 + swz / 64; C = (st & 1) * 32 + (swz % 64) / 2; }
__host__ __device__ __forceinline__ int perm32(int rho) { const int n = rho >> 4, i = rho & 15; return 8 * (i >> 2) + 4 * n + (i & 3); }

struct Unit { int pm, pn; };
struct Gemm { const bf16_t* A; const bf16_t* Bt; int M, N, K, lda, ldb, a_shift, a_step; size_t a_pm, b_pm; };

struct StaticOrder {
    int nM, nN, nwg, G, c;
    __device__ void init(int M, int N, int G_, int c_) { nM = M / BM; nN = N / BM; nwg = nM * nN; G = G_; c = c_; }
    __device__ bool next(int i, Unit& u) const {
        const long L = (long)i * G + c; if (L >= nwg) return false;
        int wgid = (int)L; { const int q = nwg / NXCD, r = nwg % NXCD, xcd = wgid % NXCD, off = wgid / NXCD; wgid = (xcd < r ? xcd * (q + 1) : r * (q + 1) + (xcd - r) * q) + off; }
        const int nig = WGM * nN, gid = wgid / nig, fm = gid * WGM, gsz = (nM - fm) < WGM ? (nM - fm) : WGM;
        u.pm = fm + ((wgid % nig) % gsz); u.pn = (wgid % nig) / gsz; return true;
    }
};

struct EpiSwiGLU {
    static constexpr bool PERM = true;
    bf16_t* O; int ldc;
    __device__ __forceinline__ void operator()(const f32x4 (&acc)[2][2][4][2], const Unit& u, int wr, int wc, int fr, int fq) const {
        const int row0 = u.pm * BM + wr * 64 + fr, col0 = u.pn * HALF + wc * 32 + 8 * fq;
#pragma unroll
        for (int ai = 0; ai < 2; ++ai)
#pragma unroll
            for (int m = 0; m < 4; ++m) { bf16_t* rowp = O + (size_t)(row0 + ai * HALF + m * 16) * ldc + col0;
                const f32x4 g0 = acc[ai][0][m][0], g1 = acc[ai][0][m][1], u0 = acc[ai][1][m][0], u1 = acc[ai][1][m][1];
                u32x4 w;
                w.x = cvt_pk_bf16(silu_f(g0[0]) * u0[0], silu_f(g0[1]) * u0[1]); w.y = cvt_pk_bf16(silu_f(g0[2]) * u0[2], silu_f(g0[3]) * u0[3]);
                w.z = cvt_pk_bf16(silu_f(g1[0]) * u1[0], silu_f(g1[1]) * u1[1]); w.w = cvt_pk_bf16(silu_f(g1[2]) * u1[2], silu_f(g1[3]) * u1[3]);
#if !defined(DIAG_NO_EPI_STORE)
                *(u32x4*)rowp = w;
#else
                if (w.x == 0x12345678u) *(u32x4*)rowp = w;
#endif
                }
    }
};
struct EpiF32 {
    static constexpr bool PERM = false;
    float* C; int ldc; const float* bias; const float* scale;
    __device__ __forceinline__ void operator()(const f32x4 (&acc)[2][2][4][2], const Unit& u, int wr, int wc, int fr, int fq) const {
        const int row0 = u.pm * BM + wr * 64 + fr, col0 = u.pn * BM + wc * 32 + 4 * fq;
        f32x4 bv[2][2], sv[2][2];
#pragma unroll
        for (int bj = 0; bj < 2; ++bj)
#pragma unroll
            for (int n = 0; n < 2; ++n) { bv[bj][n] = bias ? *(const f32x4*)(bias + col0 + bj * HALF + n * 16) : (f32x4){0.f, 0.f, 0.f, 0.f};
                sv[bj][n] = scale ? *(const f32x4*)(scale + col0 + bj * HALF + n * 16) : (f32x4){1.f, 1.f, 1.f, 1.f}; }
#pragma unroll
        for (int ai = 0; ai < 2; ++ai)
#pragma unroll
            for (int m = 0; m < 4; ++m) { float* rowp = C + (size_t)(row0 + ai * HALF + m * 16) * ldc + col0;
#pragma unroll
                for (int bj = 0; bj < 2; ++bj)
#pragma unroll
                    for (int n = 0; n < 2; ++n) *(f32x4*)(rowp + bj * HALF + n * 16) = (acc[ai][bj][m][n] + bv[bj][n]) * sv[bj][n]; }
    }
};
struct EpiBf16 {
    static constexpr bool PERM = true;
    bf16_t* O; int ldc; const float* cbias; const float* rbias; const float* cscale; const f32x2* rope;
    __device__ __forceinline__ void operator()(const f32x4 (&acc)[2][2][4][2], const Unit& u, int wr, int wc, int fr, int fq) const {
        const int row0 = u.pm * BM + wr * 64 + fr, col0 = u.pn * BM + wc * 32 + 8 * fq;
        f32x4 bv[2][2], sv[2][2];
#pragma unroll
        for (int bj = 0; bj < 2; ++bj)
#pragma unroll
            for (int n = 0; n < 2; ++n) { bv[bj][n] = cbias ? *(const f32x4*)(cbias + col0 + bj * HALF + 4 * n) : (f32x4){0.f, 0.f, 0.f, 0.f};
                sv[bj][n] = cscale ? *(const f32x4*)(cscale + col0 + bj * HALF + 4 * n) : (f32x4){1.f, 1.f, 1.f, 1.f}; }
        const bool do_rope = rope != nullptr && u.pn < 10 && u.pm < 64;
#pragma unroll
        for (int ai = 0; ai < 2; ++ai)
#pragma unroll
            for (int m = 0; m < 4; ++m) { const int row = row0 + ai * HALF + m * 16; bf16_t* rowp = O + (size_t)row * ldc + col0; const float rb = rbias ? rbias[row] : 0.f;
#pragma unroll
                for (int bj = 0; bj < 2; ++bj) { f32x4 v0 = (acc[ai][bj][m][0] + bv[bj][0] + rb) * sv[bj][0], v1 = (acc[ai][bj][m][1] + bv[bj][1] + rb) * sv[bj][1];
                    if (do_rope) { const int e0 = (col0 + bj * HALF) & 127, pos = (e0 < 64) ? (row >> 6) : (row & 63);
                        const f32x4* tb = (const f32x4*)(rope + pos * 32 + ((e0 & 63) >> 1)); const f32x4 c0 = tb[0], c1 = tb[1];
                        v0 = (f32x4){v0[0] * c0[0] - v0[1] * c0[1], v0[1] * c0[0] + v0[0] * c0[1], v0[2] * c0[2] - v0[3] * c0[3], v0[3] * c0[2] + v0[2] * c0[3]};
                        v1 = (f32x4){v1[0] * c1[0] - v1[1] * c1[1], v1[1] * c1[0] + v1[0] * c1[1], v1[2] * c1[2] - v1[3] * c1[3], v1[3] * c1[2] + v1[2] * c1[3]}; }
                    u32x4 w; w.x = cvt_pk_bf16(v0[0], v0[1]); w.y = cvt_pk_bf16(v0[2], v0[3]); w.z = cvt_pk_bf16(v1[0], v1[1]); w.w = cvt_pk_bf16(v1[2], v1[3]);
                    *(u32x4*)(rowp + bj * HALF) = w; } }
    }
};

template <class Epi>
__device__ __forceinline__ void gemm_phase(LAS unsigned char* lds, const Gemm g, const StaticOrder& S, const Epi& E, int dcls = -1) {
    int tid_ = threadIdx.x; asm volatile("" : "+v"(tid_));
    const int tid = tid_, wid = __builtin_amdgcn_readfirstlane(tid >> 6), lane = tid & 63, wr = wid >> 2, wc = wid & 3, fr = lane & 15, fq = lane >> 4;
    const int K = g.K, nt = K / BK;
    unsigned voffA[2], voffB[2];
#pragma unroll
    for (int i = 0; i < 2; ++i) { int R, C; stage_rc(tid * 16 + i * 8192, R, C); const int Rb = Epi::PERM ? ((R & ~31) + perm32(R & 31)) : R;
        voffA[i] = (unsigned)(R * g.lda + C) * 2u; voffB[i] = (unsigned)(Rb * g.ldb + C) * 2u; }
    const size_t kstep = (size_t)(BK * 2);
    const size_t hstepA = (size_t)HALF * g.lda * 2, hstepB = (size_t)HALF * g.ldb * 2;
    const size_t tstepA = g.a_pm ? g.a_pm : 2 * hstepA, tstepB = 2 * hstepB;
    const unsigned ldsw = (unsigned)wid * 1024u;
    const int aoff = lds_byte(wr * 64 + fr, fq * 8), boff = lds_byte(wc * 32 + fr, fq * 8);
#define PG8_SA(b, h) (((b) * 2 + (h)) * HTB)
#define PG8_SB(b, h) ((4 + (b) * 2 + (h)) * HTB)
#define PG8_STAGE(bufoff, gbase, voff) do { _Pragma("unroll") for (int _i = 0; _i < 2; ++_i) \
        __builtin_amdgcn_global_load_lds((const unsigned*)((const char*)(gbase) + (voff)[_i]), (LAS unsigned*)(lds + (bufoff) + ldsw + _i * 8192), 16, 0, 0); } while (0)
#define PG8_LDA(dst, b, h) do { _Pragma("unroll") for (int m = 0; m < 4; ++m) _Pragma("unroll") for (int k = 0; k < 2; ++k) dst[m][k] = *(const LAS bf16x8*)(lds + PG8_SA(b, h) + aoff + m * 2048 + k * 1024); } while (0)
#define PG8_LDB(dst, b, h) do { _Pragma("unroll") for (int n = 0; n < 2; ++n) _Pragma("unroll") for (int k = 0; k < 2; ++k) dst[n][k] = *(const LAS bf16x8*)(lds + PG8_SB(b, h) + boff + n * 2048 + k * 1024); } while (0)
#define PG8_MMA(ai, bj, At, Bt) do { __builtin_amdgcn_s_setprio(1); _Pragma("unroll") for (int m = 0; m < 4; ++m) _Pragma("unroll") for (int n = 0; n < 2; ++n) _Pragma("unroll") for (int k = 0; k < 2; ++k) \
        acc[ai][bj][m][n] = __builtin_amdgcn_mfma_f32_16x16x32_bf16(Bt[n][k], At[m][k], acc[ai][bj][m][n], 0, 0, 0); __builtin_amdgcn_s_setprio(0); } while (0)
#define PG8_WAIT_V(n) asm volatile("s_waitcnt vmcnt(" #n ")" ::: "memory")
#define PG8_WAIT_L(n) asm volatile("s_waitcnt lgkmcnt(" #n ")" ::: "memory")
#define PG8_BAR __builtin_amdgcn_s_barrier()
#define PG8_SCHED __builtin_amdgcn_sched_barrier(0)
    Unit cur, nxt; int ui = 0;
    if (!S.next(0, cur)) return;
    f32x4 acc[2][2][4][2];
#pragma unroll
    for (int a = 0; a < 2; ++a)
#pragma unroll
        for (int b = 0; b < 2; ++b)
#pragma unroll
            for (int m = 0; m < 4; ++m)
#pragma unroll
                for (int n = 0; n < 2; ++n) acc[a][b][m][n] = (f32x4){0.f, 0.f, 0.f, 0.f};
    bf16x8 At[4][2], B0[2][2], B1[2][2];
    const char* cA = (const char*)g.A + (size_t)cur.pm * tstepA + (size_t)((cur.pn >> g.a_shift) * g.a_step) * 2; const char* cB = (const char*)g.Bt + (size_t)cur.pn * tstepB + (size_t)cur.pm * g.b_pm;
    PG8_STAGE(PG8_SB(0, 0), cB, voffB); PG8_STAGE(PG8_SB(0, 1), cB + hstepB, voffB); PG8_STAGE(PG8_SA(0, 0), cA, voffA); PG8_STAGE(PG8_SA(0, 1), cA + hstepA, voffA);
    if (wr == 1) PG8_BAR;
    PG8_WAIT_V(2); PG8_BAR;
    PG8_STAGE(PG8_SB(1, 0), cB + kstep, voffB); PG8_STAGE(PG8_SA(1, 0), cA + kstep, voffA); PG8_STAGE(PG8_SB(1, 1), cB + hstepB + kstep, voffB);
    PG8_WAIT_V(6); PG8_BAR;
    for (;;) {
        const bool has_next = S.next(ui + 1, nxt);
        const char* nA = has_next ? (const char*)g.A + (size_t)nxt.pm * tstepA + (size_t)((nxt.pn >> g.a_shift) * g.a_step) * 2 : cA; const char* nB = has_next ? (const char*)g.Bt + (size_t)nxt.pn * tstepB + (size_t)nxt.pm * g.b_pm : cB;
        for (int t = 0; t < nt; t += 2) {
            const bool last = (t == nt - 2);
            const char* a1 = cA + (size_t)(t + 1) * kstep;
            const char* a2 = last ? nA : cA + (size_t)(t + 2) * kstep; const char* b2 = last ? nB : cB + (size_t)(t + 2) * kstep;
            const char* a3 = a2 + kstep; const char* b3 = b2 + kstep;
            PG8_LDB(B0, 0, 0); PG8_LDB(B1, 0, 1); PG8_SCHED; PG8_LDA(At, 0, 0); PG8_STAGE(PG8_SA(1, 1), a1 + hstepA, voffA);
            PG8_WAIT_V(8); PG8_WAIT_L(0); PG8_BAR; PG8_MMA(0, 0, At, B0); PG8_MMA(0, 1, At, B1); PG8_BAR; PG8_SCHED;
            PG8_LDA(At, 0, 1); PG8_STAGE(PG8_SB(0, 0), b2, voffB); PG8_STAGE(PG8_SB(0, 1), b2 + hstepB, voffB); PG8_STAGE(PG8_SA(0, 0), a2, voffA);
            PG8_WAIT_V(8); PG8_WAIT_L(0); PG8_BAR; PG8_MMA(1, 0, At, B0); PG8_MMA(1, 1, At, B1); PG8_BAR; PG8_SCHED;
            PG8_LDB(B0, 1, 0); PG8_LDB(B1, 1, 1); PG8_SCHED; PG8_LDA(At, 1, 0); PG8_STAGE(PG8_SA(0, 1), a2 + hstepA, voffA);
            PG8_WAIT_V(8); PG8_WAIT_L(0); PG8_BAR; PG8_MMA(0, 0, At, B0); PG8_MMA(0, 1, At, B1); PG8_BAR; PG8_SCHED;
            PG8_LDA(At, 1, 1); PG8_STAGE(PG8_SB(1, 0), b3, voffB); PG8_STAGE(PG8_SB(1, 1), b3 + hstepB, voffB); PG8_STAGE(PG8_SA(1, 0), a3, voffA);
            PG8_WAIT_V(8); PG8_WAIT_L(0); PG8_BAR; PG8_MMA(1, 0, At, B0); PG8_MMA(1, 1, At, B1); PG8_BAR; PG8_SCHED;
        }
        if (wr == 0) PG8_BAR;
        GSTAMP(dcls);
        E(acc, cur, wr, wc, fr, fq);
        GSTAMP(dcls >= 0 ? dcls + 1 : -1);
        if (!has_next) break;
#pragma unroll
        for (int a = 0; a < 2; ++a)
#pragma unroll
            for (int b = 0; b < 2; ++b)
#pragma unroll
                for (int m = 0; m < 4; ++m)
#pragma unroll
                    for (int n = 0; n < 2; ++n) acc[a][b][m][n] = (f32x4){0.f, 0.f, 0.f, 0.f};
        cur = nxt; cA = nA; cB = nB; ++ui;
        if (wr == 1) PG8_BAR;
    }
    PG8_WAIT_V(0);
    PG8_BAR;
#undef PG8_SA
#undef PG8_SB
#undef PG8_STAGE
#undef PG8_LDA
#undef PG8_LDB
#undef PG8_MMA
#undef PG8_WAIT_V
#undef PG8_WAIT_L
#undef PG8_BAR
#undef PG8_SCHED
}
}

#define XB_TMO      128
#define XB_XCNT(j)  (256  + 64 * (j))
#define XB_XSUB(j)  (1280 + 64 * (j))
#define XB_XGEN(j)  (2304 + 64 * (j))
#define XB_TOP      3328
#define XB_TOPGEN   3392
#define XCD_BAR_WORDS 3456
#define XB_SPIN_CAP (1u << 18)
__device__ __forceinline__ unsigned xb_ld(unsigned* p)              { return __hip_atomic_load(p, __ATOMIC_RELAXED, __HIP_MEMORY_SCOPE_AGENT); }
__device__ __forceinline__ unsigned xb_add(unsigned* p, unsigned v) { return __hip_atomic_fetch_add(p, v, __ATOMIC_RELAXED, __HIP_MEMORY_SCOPE_AGENT); }
__device__ __forceinline__ unsigned xb_xcc_id() { return (unsigned)__builtin_amdgcn_s_getreg((3 << 11) | 20) & 0xFu; }
#define XB_SPIN(cond, bar) do { unsigned _sp = 0; while (cond) { __builtin_amdgcn_s_sleep(1); \
    if ((++_sp & 255u) == 0u) { if (xb_ld(&(bar)[XB_TMO])) break; if (_sp > XB_SPIN_CAP) { atomicAdd(&(bar)[XB_TMO], 1u); break; } } } } while (0)
struct XcdBarrier { unsigned* bar; unsigned x; volatile LAS unsigned* st; };
__device__ __forceinline__ XcdBarrier xcd_barrier_post(unsigned* bar, volatile LAS unsigned* st) {
    XcdBarrier b; b.bar = bar; b.x = xb_xcc_id(); b.st = st;
    if (threadIdx.x == 0) (void)xb_add(&bar[XB_XCNT(b.x)], 1u);
    return b;
}
__device__ __forceinline__ void xcd_barrier_complete(unsigned* bar, unsigned x, unsigned& nloc, unsigned& nx) {
    const unsigned G = gridDim.x * gridDim.y * gridDim.z;
    unsigned sum, cnt, mine, sp = 0u;
    for (;;) {
        sum = 0u; cnt = 0u; mine = 0u;
#pragma unroll
        for (unsigned j = 0; j < 16; ++j) { const unsigned c = xb_ld(&bar[XB_XCNT(j)]); sum += c; cnt += (c > 0u) ? 1u : 0u; mine = (j == x) ? c : mine; }
        if (sum == G) break;
        __builtin_amdgcn_s_sleep(1);
        if ((++sp & 255u) == 0u) { if (xb_ld(&bar[XB_TMO])) break; if (sp > XB_SPIN_CAP) { atomicAdd(&bar[XB_TMO], 1u); break; } }
    }
    nloc = mine > 0u ? mine : 1u; nx = cnt > 0u ? cnt : 1u;
}
__device__ __forceinline__ void xcd_barrier(const XcdBarrier& b) {
    asm volatile("s_waitcnt vmcnt(0)" ::: "memory");
    __syncthreads();
    if (threadIdx.x == 0) {
        unsigned* bar = b.bar;
        __builtin_amdgcn_s_waitcnt(0);
        unsigned nloc = b.st[0], nx = b.st[1];
        if (nloc == 0u) { xcd_barrier_complete(bar, b.x, nloc, nx); b.st[0] = nloc; b.st[1] = nx; }
        const unsigned old = xb_add(&bar[XB_XSUB(b.x)], 1u);
        const unsigned gen = old / nloc;
        if (old + 1u == (gen + 1u) * nloc) {
            __builtin_amdgcn_fence(__ATOMIC_RELEASE, "agent");
            asm volatile("s_waitcnt vmcnt(0)" ::: "memory");
            const unsigned og = xb_add(&bar[XB_TOP], 1u);
            const unsigned tg = og / nx;
            if (og + 1u == (tg + 1u) * nx) xb_add(&bar[XB_TOPGEN], 1u);
            else XB_SPIN(xb_ld(&bar[XB_TOPGEN]) == tg, bar);
            __builtin_amdgcn_fence(__ATOMIC_ACQUIRE, "agent");
            xb_add(&bar[XB_XGEN(b.x)], 1u);
            asm volatile("s_waitcnt vmcnt(0)" ::: "memory");
        } else {
            XB_SPIN(xb_ld(&bar[XB_XGEN(b.x)]) == gen, bar);
            __builtin_amdgcn_fence(__ATOMIC_ACQUIRE, "agent");
            asm volatile("s_waitcnt vmcnt(0)" ::: "memory");
        }
    }
    __syncthreads();
}

__device__ __forceinline__ void xcc_local_barrier(unsigned* cnt, unsigned n, unsigned& gen) {
    asm volatile("s_waitcnt vmcnt(0)" ::: "memory");
    __syncthreads();
    if (threadIdx.x == 0) {
        (void)xb_add(cnt, 1u);
        const unsigned target = (gen + 1u) * n; unsigned sp = 0u;
        while (xb_ld(cnt) < target) { __builtin_amdgcn_s_sleep(1); if (++sp > XB_SPIN_CAP) break; }
        __builtin_amdgcn_fence(__ATOMIC_ACQUIRE, "agent");
        asm volatile("s_waitcnt vmcnt(0)" ::: "memory");
    }
    __syncthreads();
    ++gen;
}
__device__ __forceinline__ void sub_barrier(unsigned* cnt, unsigned n, unsigned& gen) {
    asm volatile("s_waitcnt vmcnt(0)" ::: "memory");
    __syncthreads();
    if (threadIdx.x == 0) {
        __builtin_amdgcn_fence(__ATOMIC_RELEASE, "agent");
        asm volatile("s_waitcnt vmcnt(0)" ::: "memory");
        (void)xb_add(cnt, 1u);
        const unsigned target = (gen + 1u) * n; unsigned sp = 0u;
        while (xb_ld(cnt) < target) { __builtin_amdgcn_s_sleep(1); if (++sp > XB_SPIN_CAP) break; }
        __builtin_amdgcn_fence(__ATOMIC_ACQUIRE, "agent");
        asm volatile("s_waitcnt vmcnt(0)" ::: "memory");
    }
    __syncthreads();
    ++gen;
}

#define FD __device__ __forceinline__
FD float hw_sin_rev(float f) { return __builtin_amdgcn_sinf(f); }
FD float hw_cos_rev(float f) { return __builtin_amdgcn_cosf(f); }
FD unsigned bitrev32(unsigned v) { return __builtin_bitreverse32(v); }
namespace fftc {
typedef float cf __attribute__((ext_vector_type(2)));
constexpr int LOGM = 14, FM = 1 << LOGM;
constexpr int FPHYS = FM + (FM >> 4) + ((FM >> 9) << 4);
FD int phys(int i) { return i + (i >> 4) + ((i >> 9) << 4); }
FD cf cmul(cf a, cf b) { return a.xx * b + a.yy * (cf){-b.y, b.x}; }
FD cf cmulp(cf a, cf w, cf wp) { return a.xx * w + a.yy * wp; }
FD cf cperp(cf w) { return (cf){-w.y, w.x}; }
FD cf cconj(cf a) { return (cf){a.x, -a.y}; }
FD cf c32(int m) {
    constexpr float C[16] = {1.0f, 0.9807852804032304f, 0.9238795325112867f, 0.8314696123025452f, 0.7071067811865476f, 0.5555702330196022f, 0.3826834323650898f, 0.19509032201612825f,
                             0.0f, -0.19509032201612825f, -0.3826834323650898f, -0.5555702330196022f, -0.7071067811865476f, -0.8314696123025452f, -0.9238795325112867f, -0.9807852804032304f};
    constexpr float S[16] = {0.0f, 0.19509032201612825f, 0.3826834323650898f, 0.5555702330196022f, 0.7071067811865476f, 0.8314696123025452f, 0.9238795325112867f, 0.9807852804032304f,
                             1.0f, 0.9807852804032304f, 0.9238795325112867f, 0.8314696123025452f, 0.7071067811865476f, 0.5555702330196022f, 0.3826834323650898f, 0.19509032201612825f};
    return (cf){C[m], -S[m]};
}
FD cf twid(int e) { const float f = (float)(e & (FM - 1)) * (1.0f / (float)FM); return (cf){hw_cos_rev(f), -hw_sin_rev(f)}; }
FD int rev14(int p) { return (int)(bitrev32((unsigned)p) >> (32 - LOGM)); }

template <bool CONJ> FD cf mul_c32(cf d, int m) {
    if (m == 0) return d;
    if (m == 8) return CONJ ? (cf){-d.y, d.x} : (cf){d.y, -d.x};
    const cf c = CONJ ? cconj(c32(m)) : c32(m);
    return cmul(d, c);
}
template <int S0, int G, bool INV, int NT, int PRUNE = 0>
FD void fft_pass(LAS cf* X, int tid) {
    constexpr int R = 1 << G;
    constexpr int LOGHG = LOGM - S0 - G, HG = 1 << LOGHG;
    constexpr int NGRP = FM >> G;
    for (int gid = tid; gid < NGRP; gid += NT) {
        const int lo = gid & (HG - 1), hi = gid >> LOGHG, base = (hi << (LOGHG + G)) + lo;
        cf v[R];
#pragma unroll
        for (int q = 0; q < R; ++q) { if (PRUNE == 1 && q >= R / 2) v[q] = (cf){0.f, 0.f}; else v[q] = X[phys(base + q * HG)]; }
        cf Tp[G];
        if (HG > 1) { Tp[0] = twid(lo << S0); if (INV) Tp[0] = cconj(Tp[0]);
#pragma unroll
            for (int st = 1; st < G; ++st) Tp[st] = cmul(Tp[st - 1], Tp[st - 1]); }
#pragma unroll
        for (int sti = 0; sti < G; ++sti) {
            const int st = INV ? (G - 1 - sti) : sti;
            const int dq = R >> (st + 1);
#pragma unroll
            for (int qq = 0; qq < dq; ++qq) {
                const int m = qq * 16 / dq;
                cf W = (cf){1.f, 0.f}, Wp = (cf){0.f, 1.f};
                if (HG > 1) { W = mul_c32<INV>(Tp[st], m); Wp = cperp(W); }
#pragma unroll
                for (int blk = 0; blk < R / (2 * dq); ++blk) {
                    const int q = blk * 2 * dq + qq;
                    const cf a = v[q], b = v[q + dq];
                    if (!INV) { if (PRUNE == 1 && st == 0) { v[q + dq] = (HG > 1) ? cmulp(a, W, Wp) : mul_c32<false>(a, m); }
                        else { v[q] = a + b; cf d = a - b; v[q + dq] = (HG > 1) ? cmulp(d, W, Wp) : mul_c32<false>(d, m); } }
                    else { const cf bb = (HG > 1) ? cmulp(b, W, Wp) : mul_c32<true>(b, m); v[q] = a + bb; if (!(PRUNE == 2 && st == 0)) v[q + dq] = a - bb; }
                }
            }
        }
#pragma unroll
        for (int q = 0; q < R; ++q) { if (!(PRUNE == 2 && q >= R / 2)) X[phys(base + q * HG)] = v[q]; }
    }
}
FD void pair_pos(int q, int& p, int& p2, int& k) { p = 2 * q; k = rev14(p); p2 = rev14((FM - k) & (FM - 1)); }
FD cf wk2(int k) { const float f = (float)k * (0.5f / (float)FM); return (cf){hw_cos_rev(f), -hw_sin_rev(f)}; }
FD void real_unpack(cf Zk, cf Zk2, cf w, cf& Xk, cf& Xmk) {
    const cf Zc = cconj(Zk2);
    const cf E = 0.5f * (Zk + Zc);
    const cf Dm = 0.5f * (Zk - Zc);
    const cf O = (cf){Dm.y, -Dm.x};
    const cf WO = cmul(w, O);
    Xk = E + WO; Xmk = cconj(E - WO);
}
FD void real_pack(cf Yk, cf Ymk, cf w, cf& Zk, cf& Zk2) {
    const cf Yc = cconj(Ymk);
    const cf Ey = 0.5f * (Yk + Yc);
    const cf Dd = 0.5f * (Yk - Yc);
    const cf Oy = cmul(cconj(w), Dd);
    Zk = (cf){Ey.x - Oy.y, Ey.y + Oy.x};
    Zk2 = (cf){Ey.x + Oy.y, -Ey.y + Oy.x};
}
FD int rev10(int v) { return (int)(bitrev32((unsigned)v) >> 22); }
constexpr int rev4c(int v) { return ((v & 1) << 3) | ((v & 2) << 1) | ((v & 4) >> 1) | ((v & 8) >> 3); }
constexpr int blk0_partner(int e) { return rev4c((16 - rev4c(e)) & 15); }
FD void mid_blocks(int tid, int& a, int& gA, int& gB) { a = ((tid & 31) << 4) | (tid >> 5); gA = (tid == 0) ? 0 : rev10(a); gB = (tid == 0) ? 1 : rev10(1024 - a); }
FD int fp_index(int q) { const int g = q >> 3, j = q & 7; int a, set; if ((g & 1) == 0) { a = rev10(g); set = 0; } else { a = (1024 - rev10(g)) & 511; set = 1; }
    const int tid = ((a & 15) << 5) | (a >> 4); return (tid * 2 + set) * 8 + j; }
template <bool INV> FD void bfly16(cf (&v)[16]) {
#pragma unroll
    for (int sti = 0; sti < 4; ++sti) { const int st = INV ? 3 - sti : sti, dq = 16 >> (st + 1);
#pragma unroll
        for (int qq = 0; qq < dq; ++qq) { const int m = qq * 16 / dq;
#pragma unroll
            for (int blk = 0; blk < 16 / (2 * dq); ++blk) { const int q = blk * 2 * dq + qq; const cf a = v[q], b = v[q + dq];
                if (!INV) { v[q] = a + b; v[q + dq] = mul_c32<false>(a - b, m); } else { const cf bb = mul_c32<true>(b, m); v[q] = a + bb; v[q + dq] = a - bb; } } } }
}
FD void pair_apply(cf& own, cf& par, const f32x4 f, const cf wk) {
    cf Xk, Xmk; real_unpack(own, par, wk, Xk, Xmk);
    const cf Yk = cmul(Xk, (cf){f[0], f[1]}), Ymk = cmul(Xmk, (cf){f[2], f[3]});
    cf Zk, Zk2; real_pack(Yk, Ymk, wk, Zk, Zk2); own = Zk; par = Zk2;
}
FD f32x4 unpack_bf16x4(u32x2 r) { return (f32x4){bflo(r.x), bfhi(r.x), bflo(r.y), bfhi(r.y)}; }
FD void fft_mid(LAS cf* X, int tid, const u32x2* Fp) {
    int a, gA, gB; mid_blocks(tid, a, gA, gB);
    LAS cf* pA = X + phys(16 * gA); LAS cf* pB = X + phys(16 * gB);
    cf vA[16], vB[16];
#pragma unroll
    for (int q = 0; q < 16; ++q) { vA[q] = pA[q]; vB[q] = pB[q]; }
    u32x2 fr[16];
#pragma unroll
    for (int i = 0; i < 16; ++i) fr[i] = Fp[tid * 16 + i];
    bfly16<false>(vA); bfly16<false>(vB);
    const cf twA = wk2((tid == 0) ? 0 : a), twB = wk2((tid == 0) ? 512 : 1024 - a);
    if (tid != 0) {
#pragma unroll
        for (int j = 0; j < 8; ++j) { const cf c = c32(rev4c(2 * j));
            pair_apply(vA[2 * j], vB[15 - 2 * j], unpack_bf16x4(fr[j]), cmul(c, twA));
            pair_apply(vB[2 * j], vA[15 - 2 * j], unpack_bf16x4(fr[8 + j]), cmul(c, twB)); }
    } else {
        { const f32x4 f = unpack_bf16x4(fr[0]); const cf Z0 = vA[0], Zh = vA[1];
          const float Y0 = (Z0.x + Z0.y) * f[0], YM = (Z0.x - Z0.y) * f[2];
          vA[0] = (cf){0.5f * (Y0 + YM), 0.5f * (Y0 - YM)}; const cf Yh = cmul(cconj(Zh), (cf){f[1], f[3]}); vA[1] = cconj(Yh); }
#pragma unroll
        for (int j = 1; j < 8; ++j) pair_apply(vA[2 * j], vA[blk0_partner(2 * j)], unpack_bf16x4(fr[j]), cmul(c32(rev4c(2 * j)), twA));
#pragma unroll
        for (int j = 0; j < 8; ++j) pair_apply(vB[2 * j], vB[15 - 2 * j], unpack_bf16x4(fr[8 + j]), cmul(c32(rev4c(2 * j)), twB));
    }
    bfly16<true>(vA); bfly16<true>(vB);
#pragma unroll
    for (int q = 0; q < 16; ++q) { pA[q] = vA[q]; pB[q] = vB[q]; }
}
FD void fft_mid_filter(LAS cf* X, int tid, bf16_t* row, float sc) {
    int a, gA, gB; mid_blocks(tid, a, gA, gB);
    const LAS cf* pA = X + phys(16 * gA); const LAS cf* pB = X + phys(16 * gB);
    cf vA[16], vB[16];
#pragma unroll
    for (int q = 0; q < 16; ++q) { vA[q] = pA[q]; vB[q] = pB[q]; }
    bfly16<false>(vA); bfly16<false>(vB);
    const cf twA = wk2((tid == 0) ? 0 : a), twB = wk2((tid == 0) ? 512 : 1024 - a);
    u32x2 o[16];
#define FMF_PUT_(idx, own, par, wkv) do { cf Xk_, Xmk_; real_unpack(own, par, wkv, Xk_, Xmk_); o[idx].x = cvt_pk_bf16(Xk_.x * sc, Xk_.y * sc); o[idx].y = cvt_pk_bf16(Xmk_.x * sc, Xmk_.y * sc); } while (0)
    if (tid != 0) {
#pragma unroll
        for (int j = 0; j < 8; ++j) { const cf c = c32(rev4c(2 * j));
            FMF_PUT_(j, vA[2 * j], vB[15 - 2 * j], cmul(c, twA));
            FMF_PUT_(8 + j, vB[2 * j], vA[15 - 2 * j], cmul(c, twB)); }
    } else {
        { const cf Z0 = vA[0], Zh = vA[1]; o[0].x = cvt_pk_bf16((Z0.x + Z0.y) * sc, Zh.x * sc); o[0].y = cvt_pk_bf16((Z0.x - Z0.y) * sc, -Zh.y * sc); }
#pragma unroll
        for (int j = 1; j < 8; ++j) FMF_PUT_(j, vA[2 * j], vA[blk0_partner(2 * j)], cmul(c32(rev4c(2 * j)), twA));
#pragma unroll
        for (int j = 0; j < 8; ++j) FMF_PUT_(8 + j, vB[2 * j], vB[15 - 2 * j], cmul(c32(rev4c(2 * j)), twB));
    }
#undef FMF_PUT_
    u32x4* dst = (u32x4*)(row + 64 * tid);
#pragma unroll
    for (int i = 0; i < 8; ++i) dst[i] = (u32x4){o[2 * i].x, o[2 * i].y, o[2 * i + 1].x, o[2 * i + 1].y};
}
FD void fft_forward(LAS cf* X, int tid) {
    fft_pass<0, 5, false, NTHR>(X, tid); __syncthreads();
    fft_pass<5, 5, false, NTHR>(X, tid); __syncthreads();
    fft_pass<10, 4, false, NTHR>(X, tid); __syncthreads();
}
FD void fft_inverse(LAS cf* X, int tid) {
    fft_pass<10, 4, true, NTHR>(X, tid); __syncthreads();
    fft_pass<5, 5, true, NTHR>(X, tid); __syncthreads();
    fft_pass<0, 5, true, NTHR>(X, tid); __syncthreads();
}
}

struct Args {
    const float* in[33]; float* out; unsigned char* ws;
    double invf[32];
};
enum { I_X = 0, I_C, I_CTX, I_CCTX, I_WADA, I_BADA, I_NPRE, I_NPOST, I_WFIN, I_WFOUT, I_HWIN, I_HBIN, I_HWSC, I_HBSC, I_FW1, I_FB1, I_FW2, I_FB2, I_FW3, I_FB3, I_FW4, I_FFREQ, I_HSKIP, I_HWOUT, I_HBOUT,
       I_AWQKV, I_ABQKV, I_ASINK, I_AWO, I_ABO, I_PW, I_PB, I_PSCALE };

__device__ __forceinline__ const CAS char* kargs() { const CAS char* p = (const CAS char*)__builtin_amdgcn_kernarg_segment_ptr(); asm volatile("" : "+s"(p)); return p; }
#define IN(i) (*(const float* const CAS*)(kargs() + 8 * (i)))
#define OUTP (*(float* const CAS*)(kargs() + 8 * 33))
#define WSP (*(unsigned char* const CAS*)(kargs() + 8 * 34))
#define INVF(j) (*(const CAS double*)(kargs() + 8 * 35 + 8 * (j)))
struct Frame {
    LAS unsigned char* lds;
    int tid, lane, wave, G, bid, vcu;
    unsigned char* ws;
};
__device__ __forceinline__ LAS unsigned char* lds_dyn() { extern __shared__ __attribute__((aligned(16))) unsigned char lds_raw[]; return (LAS unsigned char*)lds_raw; }
__device__ __forceinline__ Frame mk_frame() {
    extern __shared__ __attribute__((aligned(16))) unsigned char lds_raw[];
    Frame F; int tid = threadIdx.x; asm volatile("" : "+v"(tid));
    F.lds = (LAS unsigned char*)lds_raw; F.tid = tid; F.lane = tid & 63; F.wave = __builtin_amdgcn_readfirstlane(tid >> 6);
    F.G = gridDim.x; F.bid = blockIdx.x; F.ws = WSP;
    F.vcu = (int)((volatile LAS unsigned*)(F.lds + MISC_OFF))[18]; return F;
}
__device__ __forceinline__ Frame mk_frame_group(int first, int n) { Frame F = mk_frame(); F.bid = (int)blockIdx.x - first; F.G = n; F.vcu = F.bid; return F; }

__device__ __forceinline__ int srccol(int r, int mode) {
    if (mode == 1) { const int pn = r >> 8, w = r & 255; return (w < 128) ? (128 * pn + w) : (DFF + 128 * pn + (w - 128)); }
    if (mode == 2 && r < 2560) { const int e = r & 127, f = e & 63; return (r & ~127) + (e & 64) + (f & 1) * 32 + (f >> 1); }
    return r;
}
struct CvtDesc { const float* W; bf16_t* WT; int K, N, mode, ldw, item; };
__device__ __forceinline__ void cvt_load(const CvtDesc& d, int lane, float (&wv)[32]) {
    const int nblk = d.N / 32, kb = d.item / nblk, nb = d.item % nblk, k0 = 64 * kb, r0 = 32 * nb;
    const int ncol = srccol(r0 + (lane & 31), d.mode);
#pragma unroll
    for (int i = 0; i < 32; ++i) wv[i] = __builtin_nontemporal_load(d.W + (size_t)(k0 + 2 * i + (lane >> 5)) * d.N + ncol);
}
__device__ __forceinline__ void cvt_store(const CvtDesc& d, int lane, const float (&wv)[32], LAS float* scr) {
    const int nblk = d.N / 32, kb = d.item / nblk, nb = d.item % nblk, k0 = 64 * kb, r0 = 32 * nb;
#pragma unroll
    for (int i = 0; i < 32; ++i) scr[(2 * i + (lane >> 5)) * 33 + (lane & 31)] = wv[i];
    LDS_WAIT(); asm volatile("" ::: "memory");
    const int c = lane & 7;
#pragma unroll
    for (int j = 0; j < 4; ++j) { const int n = (lane >> 3) + 8 * j; const LAS float* s = scr + (8 * c) * 33 + n;
        u32x4 o; o.x = cvt_pk_bf16(s[0 * 33], s[1 * 33]); o.y = cvt_pk_bf16(s[2 * 33], s[3 * 33]); o.z = cvt_pk_bf16(s[4 * 33], s[5 * 33]); o.w = cvt_pk_bf16(s[6 * 33], s[7 * 33]);
        *(u32x4*)(d.WT + (size_t)(r0 + n) * d.ldw + k0 + 8 * c) = o; }
    LDS_WAIT(); asm volatile("" ::: "memory");
}
namespace cvt {
constexpr int I_IN = (D / 64) * (2 * DFF / 32), I_OUT = (DFF / 64) * (D / 32), I_HI = (D / 64) * (3 * D / 32), I_SQ = (D / 64) * (D / 32), I_QK = (D / 64) * (QKVD / 32), I_PL = (512 / 64) * (512 / 32);
constexpr int N0 = 3 * I_IN + 3 * I_OUT + I_HI + I_SQ + I_QK;
constexpr int N1 = 5 * I_IN + 5 * I_OUT + I_HI + I_SQ + I_SQ + 4 * I_PL;
}
__device__ __forceinline__ CvtDesc cvt_win(const Frame& F, int j, int r) { return CvtDesc{IN(I_WFIN) + (size_t)j * D * 2 * DFF, (bf16_t*)(F.ws + WS_WIN) + (size_t)j * 2 * DFF * D, D, 2 * DFF, 1, D, r}; }
__device__ __forceinline__ CvtDesc cvt_wout(const Frame& F, int j, int r) { return CvtDesc{IN(I_WFOUT) + (size_t)j * DFF * D, (bf16_t*)(F.ws + WS_WOUT) + (size_t)j * WOUT_STRIDE, DFF, D, 0, DFFP, r}; }
__device__ __forceinline__ CvtDesc cvt_hin(const Frame& F, int j, int r) { return CvtDesc{IN(I_HWIN) + (size_t)j * D * 3 * D, (bf16_t*)(F.ws + WS_WHIN) + (size_t)j * 3 * D * D, D, 3 * D, 0, D, r}; }
__device__ __forceinline__ CvtDesc cvt_hout(const Frame& F, int j, int r) { return CvtDesc{IN(I_HWOUT) + (size_t)j * D * D, (bf16_t*)(F.ws + WS_WHOUT) + (size_t)j * D * D, D, D, 0, D, r}; }
__device__ __forceinline__ CvtDesc cvt_desc(const Frame& F, int list, int it) {
    using namespace cvt;
    if (list == 0) {
        if (it < 3 * I_IN) return cvt_win(F, it / I_IN, it % I_IN); it -= 3 * I_IN;
        if (it < 3 * I_OUT) return cvt_wout(F, it / I_OUT, it % I_OUT); it -= 3 * I_OUT;
        if (it < I_HI) return cvt_hin(F, 0, it); it -= I_HI;
        if (it < I_SQ) return cvt_hout(F, 0, it); it -= I_SQ;
        return CvtDesc{IN(I_AWQKV), (bf16_t*)(F.ws + WS_WQKV), D, QKVD, 2, D, it};
    }
    if (it < 5 * I_IN) return cvt_win(F, 3 + it / I_IN, it % I_IN); it -= 5 * I_IN;
    if (it < 5 * I_OUT) return cvt_wout(F, 3 + it / I_OUT, it % I_OUT); it -= 5 * I_OUT;
    if (it < I_HI) return cvt_hin(F, 1, it); it -= I_HI;
    if (it < I_SQ) return cvt_hout(F, 1, it); it -= I_SQ;
    if (it < I_SQ) return CvtDesc{IN(I_AWO), (bf16_t*)(F.ws + WS_WO), D, D, 0, D, it}; it -= I_SQ;
    { const int j = it / I_PL; return CvtDesc{IN(I_PW) + (size_t)j * 512 * 512, (bf16_t*)(F.ws + WS_WP) + (size_t)j * 512 * 512, 512, 512, 0, 512, it % I_PL}; }
}
__device__ __forceinline__ void p0_convert(const Frame& F, int wsub, int nw, int list) {
    LAS float* scr = (LAS float*)(F.lds + wsub * 8704);
    const int gw = F.bid * nw + wsub, NGW = F.G * nw;
    const int NIT = list == 0 ? cvt::N0 : cvt::N1;
    int it = gw; if (it >= NIT) return;
    float va[32], vb[32];
    CvtDesc da = cvt_desc(F, list, it), db = da;
    cvt_load(da, F.lane, va);
    for (;;) {
        const int itb = it + NGW; const bool hb = itb < NIT;
        if (hb) { db = cvt_desc(F, list, itb); cvt_load(db, F.lane, vb); }
        cvt_store(da, F.lane, va, scr);
        if (!hb) break;
        const int ita = itb + NGW; const bool ha = ita < NIT;
        if (ha) { da = cvt_desc(F, list, ita); cvt_load(da, F.lane, va); }
        cvt_store(db, F.lane, vb, scr);
        if (!ha) break;
        it = ita;
    }
}

__device__ __forceinline__ void p0_mods(const Frame& F) {
    LAS float* sc = (LAS float*)(F.lds + 69632);
    LAS float* red = sc + 4096;
    { const float* cp = IN(I_C); const float* ccp = IN(I_CCTX);
      for (int i = F.tid; i < D; i += NTHR) { sc[i] = silu_f(cp[i]); sc[D + i] = silu_f(ccp[i]); } }
    __syncthreads();
    float* mod = (float*)(F.ws + WS_MOD); float* modc = (float*)(F.ws + WS_MOD + 512 * 1024);
    const float* bada = IN(I_BADA); const float* wada = IN(I_WADA);
    constexpr int NCOL = DEPTH * NMOD * D, CPB = 288, NG = CPB / 32;
    for (int fc0 = F.bid * CPB; fc0 < NCOL; fc0 += F.G * CPB) {
        const int l = fc0 / (NMOD * D), j0 = fc0 % (NMOD * D), cl = F.lane & 31, rp = F.lane >> 5;
        const float* wp = wada + ((size_t)l * D + (size_t)F.wave * 256 + rp) * (NMOD * D) + j0 + cl;
        float a0[NG], a1[NG];
#pragma unroll
        for (int g = 0; g < NG; ++g) { a0[g] = 0.f; a1[g] = 0.f; }
#pragma unroll 4
        for (int kk = 0; kk < 128; ++kk) {
            const float s0 = sc[F.wave * 256 + 2 * kk + rp], s1 = sc[D + F.wave * 256 + 2 * kk + rp];
#pragma unroll
            for (int g = 0; g < NG; ++g) { const float w = __builtin_nontemporal_load(wp + (size_t)(2 * kk) * (NMOD * D) + 32 * g); a0[g] += w * s0; a1[g] += w * s1; } }
#pragma unroll
        for (int g = 0; g < NG; ++g) { a0[g] += __shfl_xor(a0[g], 32); a1[g] += __shfl_xor(a1[g], 32); }
        if (rp == 0) {
#pragma unroll
            for (int g = 0; g < NG; ++g) { red[(F.wave * 2 + 0) * CPB + 32 * g + cl] = a0[g]; red[(F.wave * 2 + 1) * CPB + 32 * g + cl] = a1[g]; } }
        __syncthreads();
        for (int i = F.tid; i < 2 * CPB; i += NTHR) { const int sidx = i / CPB, col = i % CPB; float v = 0.f;
#pragma unroll
            for (int w = 0; w < 8; ++w) v += red[(w * 2 + sidx) * CPB + col];
            const int j = j0 + col; v += bada[l * (NMOD * D) + j];
            if (sidx == 0) mod[l * (NMOD * D) + j] = v; else if (l < 2) modc[l * (NMOD * D) + j] = v; }
        __syncthreads();
    }
}

__device__ __forceinline__ void p0_rope(const Frame& F) {
    f32x2* tab = (f32x2*)(F.ws + WS_ROPE);
    for (int i = F.bid * NTHR + F.tid; i < 256 * 32; i += F.G * NTHR) {
        const int pos = i >> 5, j = i & 31;
        const double rev = (double)pos * INVF(j) * 0.15915494309189535;
        const float fr = (float)(rev - floor(rev));
        tab[i] = (f32x2){__builtin_amdgcn_cosf(fr), __builtin_amdgcn_sinf(fr)};
    }
    float* bqp = (float*)(F.ws + WS_BQP); const float* bq = IN(I_ABQKV); const float* hbo = IN(I_HBOUT);
    for (int i = F.bid * NTHR + F.tid; i < QKVD + 2 * D; i += F.G * NTHR) bqp[i] = (i < QKVD) ? bq[srccol(i, 2)] : 0.25f * hbo[i - QKVD];
}

__device__ __forceinline__ float sin_rad(float x) { const float r = x * 0.15915494309189535f; return __builtin_amdgcn_sinf(r - floorf(r)); }
__device__ __forceinline__ void p0_hidden(const Frame& F, int wsub, int nw, int set_lo, int set_hi) {
    LAS float* hb = (LAS float*)(F.lds + 102400 + F.wave * 2048);
    const int lane = F.lane;
    for (int set = set_lo; set < set_hi; ++set)
    for (int tb = F.bid; tb < ((set == 2) ? CTX : SEQ) / (4 * nw); tb += F.G) {
        const int hj = (set == 1) ? 1 : 0, L = (set == 2) ? CTX : SEQ, t0 = (tb * nw + wsub) * 4;
        const float* w1 = IN(I_FW1) + hj * 33 * 64; const float* b1 = IN(I_FB1) + hj * 64;
        const float* w2 = IN(I_FW2) + hj * 64 * 64; const float* b2 = IN(I_FB2) + hj * 64;
        const float* w3 = IN(I_FW3) + hj * 64 * 64; const float* b3 = IN(I_FB3) + hj * 64;
        const float* fq = IN(I_FFREQ) + hj * 3 * 64;
        if (lane < 33) {
#pragma unroll
            for (int e = 0; e < 4; ++e) { const int t = t0 + e; float z;
                if (lane == 0) z = (float)t / (float)(L - 1);
                else { const int bi = (lane - 1) & 15; const double band = 1e-4 + (double)bi * ((15.0 - 1e-4) / 15.0); const double rev = band * (double)t / (double)L; const float fr = (float)(rev - floor(rev));
                    z = (lane <= 16) ? __builtin_amdgcn_cosf(fr) : -__builtin_amdgcn_sinf(fr); }
                hb[e * 128 + lane] = z; }
        }
        LDS_WAIT(); __builtin_amdgcn_wave_barrier();
        float acc[4], f[4];
#pragma unroll
        for (int e = 0; e < 4; ++e) acc[e] = b1[lane];
#pragma unroll 11
        for (int i = 0; i < 33; ++i) { const float w = w1[i * 64 + lane];
#pragma unroll
            for (int e = 0; e < 4; ++e) acc[e] += hb[e * 128 + i] * w; }
#pragma unroll
        for (int e = 0; e < 4; ++e) f[e] = sin_rad(fq[lane] * acc[e]);
        LDS_WAIT(); __builtin_amdgcn_wave_barrier();
#pragma unroll
        for (int e = 0; e < 4; ++e) hb[e * 128 + 64 + lane] = f[e];
        LDS_WAIT(); __builtin_amdgcn_wave_barrier();
#pragma unroll
        for (int e = 0; e < 4; ++e) acc[e] = b2[lane];
#pragma unroll 16
        for (int i = 0; i < 64; ++i) { const float w = w2[i * 64 + lane];
#pragma unroll
            for (int e = 0; e < 4; ++e) acc[e] += hb[e * 128 + 64 + i] * w; }
#pragma unroll
        for (int e = 0; e < 4; ++e) f[e] = sin_rad(fq[64 + lane] * acc[e]);
        LDS_WAIT(); __builtin_amdgcn_wave_barrier();
#pragma unroll
        for (int e = 0; e < 4; ++e) hb[e * 128 + lane] = f[e];
        LDS_WAIT(); __builtin_amdgcn_wave_barrier();
#pragma unroll
        for (int e = 0; e < 4; ++e) acc[e] = b3[lane];
#pragma unroll 16
        for (int i = 0; i < 64; ++i) { const float w = w3[i * 64 + lane];
#pragma unroll
            for (int e = 0; e < 4; ++e) acc[e] += hb[e * 128 + i] * w; }
#pragma unroll
        for (int e = 0; e < 4; ++e) ((float*)(F.ws + WS_HID))[((size_t)set * SEQ + t0 + e) * 64 + lane] = sin_rad(fq[128 + lane] * acc[e]);
        LDS_WAIT(); __builtin_amdgcn_wave_barrier();
    }
}

typedef float f32x16 __attribute__((ext_vector_type(16)));
__device__ __forceinline__ void split_hilo(const float (&v)[8], bf16x8& hi, bf16x8& lo) {
    u32x4 h, l;
#pragma unroll
    for (int e = 0; e < 4; ++e) { const unsigned hw = cvt_pk_bf16(v[2 * e], v[2 * e + 1]); h[e] = hw; l[e] = cvt_pk_bf16(v[2 * e] - bflo(hw), v[2 * e + 1] - bfhi(hw)); }
    hi = __builtin_bit_cast(bf16x8, h); lo = __builtin_bit_cast(bf16x8, l);
}
typedef float f32x16v __attribute__((ext_vector_type(16)));
template <bool CTXSET> __device__ __forceinline__ void p0_filter_td(const Frame& F, int wsub, int nw, int it_lo, int it_hi) {
    const int hf = F.lane >> 5, li = F.lane & 31;
    const float* w4base = IN(I_FW4);
    for (int it = it_lo + F.bid; it < it_hi; it += F.G) {
        const int dir = it & 1, i2 = it >> 1;
        int set, cg, tq, ntile; if (i2 < 512) { set = i2 >> 8; cg = (i2 & 255) >> 2; tq = i2 & 3; ntile = 128; } else { set = 2; cg = i2 - 512; tq = 0; ntile = 8; }
        const int hj = (set == 1) ? 1 : 0, L = (set == 2) ? CTX : SEQ, L2 = 2 * L, c0 = cg * 32;
        const float* w4 = w4base + (size_t)hj * 64 * 2 * D + dir * D;
        bf16x8 Ah[4], Al[4];
#pragma unroll
        for (int ks = 0; ks < 4; ++ks) { float v[8];
#pragma unroll
            for (int jj = 0; jj < 8; ++jj) v[jj] = w4[(16 * ks + 8 * hf + jj) * (2 * D) + c0 + li];
            split_hilo(v, Ah[ks], Al[ks]); }
        float* outc = (float*)(F.ws + WS_FILTC); bf16_t* outb = (bf16_t*)(F.ws + WS_FILT + (size_t)(set & 1) * 128 * MiB);
        const float* hid = (const float*)(F.ws + WS_HID) + (size_t)set * SEQ * 64;
        f32x4 Bv[8], Bn[8];
        int tile = tq * 128 + wsub; const int tend = tq * 128 + ntile;
        if (tile < tend) { const int t = tile * 32 + li;
#pragma unroll
            for (int ks = 0; ks < 4; ++ks) { Bv[2 * ks] = *(const f32x4*)(hid + (size_t)t * 64 + 16 * ks + 8 * hf); Bv[2 * ks + 1] = *(const f32x4*)(hid + (size_t)t * 64 + 16 * ks + 8 * hf + 4); } }
        for (; tile < tend; tile += nw) {
            const int t = tile * 32 + li;
            const bool hn = tile + nw < tend;
            if (hn) { const int tn2 = (tile + nw) * 32 + li;
#pragma unroll
                for (int ks = 0; ks < 4; ++ks) { Bn[2 * ks] = *(const f32x4*)(hid + (size_t)tn2 * 64 + 16 * ks + 8 * hf); Bn[2 * ks + 1] = *(const f32x4*)(hid + (size_t)tn2 * 64 + 16 * ks + 8 * hf + 4); } }
            f32x16v acc;
#pragma unroll
            for (int r = 0; r < 16; ++r) acc[r] = 0.f;
#pragma unroll
            for (int ks = 0; ks < 4; ++ks) {
                const float v[8] = {Bv[2 * ks][0], Bv[2 * ks][1], Bv[2 * ks][2], Bv[2 * ks][3], Bv[2 * ks + 1][0], Bv[2 * ks + 1][1], Bv[2 * ks + 1][2], Bv[2 * ks + 1][3]};
                bf16x8 bh, bl; split_hilo(v, bh, bl);
                acc = __builtin_amdgcn_mfma_f32_32x32x16_bf16(Al[ks], bh, acc, 0, 0, 0);
                acc = __builtin_amdgcn_mfma_f32_32x32x16_bf16(Ah[ks], bl, acc, 0, 0, 0);
                acc = __builtin_amdgcn_mfma_f32_32x32x16_bf16(Ah[ks], bh, acc, 0, 0, 0);
            }
            const float tn = (float)t / (float)(L - 1);
#pragma unroll
            for (int r = 0; r < 16; ++r) { const int c = c0 + (r & 3) + 8 * (r >> 2) + 4 * hf;
                const float lin = -3.0701134573253943f + (float)c * ((-15.350567286626972f + 3.0701134573253943f) / (float)(D - 1));
                const float dec = __builtin_amdgcn_exp2f(-1.4426950408889634f * tn * fabsf(lin));
                const float val = acc[r] * dec;
                if (CTXSET) { float* orow = outc + (size_t)c * L2;
                    if (dir == 0) orow[t] = val; else { if (t == 0) orow[L] = 0.f; else orow[L2 - t] = val; } }
                else { bf16_t* orow = outb + (size_t)c * L2;
                    if (dir == 0) orow[t] = f2bf(val); else { if (t == 0) orow[L] = (bf16_t)0; else orow[L2 - t] = f2bf(val); } } }
            if (hn) {
#pragma unroll
                for (int j = 0; j < 8; ++j) Bv[j] = Bn[j]; }
        }
    }
}

__device__ __forceinline__ void p0_filter_fft(const Frame& F) {
    using namespace fftc;
    LAS cf* X = (LAS cf*)F.lds;
    for (int it = F.bid; it < 2 * D; it += F.G) {
        int tid = F.tid; asm volatile("" : "+v"(tid));
        bf16_t* row = (bf16_t*)(F.ws + WS_FILT + (size_t)(it / D) * 128 * MiB) + (size_t)(it % D) * (2 * SEQ);
#pragma unroll
        for (int i = tid; i < FM / 4; i += NTHR) { const u32x4 v = *(const u32x4*)(row + 8 * i); LAS cf* d = X + phys(4 * i);
            d[0] = (cf){bflo(v[0]), bfhi(v[0])}; d[1] = (cf){bflo(v[1]), bfhi(v[1])}; d[2] = (cf){bflo(v[2]), bfhi(v[2])}; d[3] = (cf){bflo(v[3]), bfhi(v[3])}; }
        __syncthreads();
        unsigned pfn = 0u;
        if (it + F.G < 2 * D) { const int nx = it + F.G; pfn = *(const unsigned*)((const bf16_t*)(F.ws + WS_FILT + (size_t)(nx / D) * 128 * MiB) + (size_t)(nx % D) * (2 * SEQ) + 64 * tid); }
        fft_pass<0, 5, false, NTHR>(X, tid); __syncthreads();
        fft_pass<5, 5, false, NTHR>(X, tid); __syncthreads();
        asm volatile("" :: "v"(pfn));
        fft_mid_filter(X, tid, row, 1.0f / (float)FM);
        __syncthreads();
    }
}

__device__ __forceinline__ void thin_phase(const Frame& F, int ph, bool ctx) {
    LAS float* cA = (LAS float*)F.lds;
    LAS float* cB = cA + D; LAS float* cC = cA + 2 * D;
    const float* mod = ctx ? (const float*)(F.ws + WS_MOD + 512 * 1024) : (const float*)(F.ws + WS_MOD);
    const int l = ph / 3, k = ph % 3, pl = (ph - 1) / 3, pk = (ph - 1) % 3;
    const bool has_prev = ph >= 1, has_next = ph < 12;
    const float* npost = IN(I_NPOST); const float* npre = IN(I_NPRE); const float* xin = ctx ? IN(I_CTX) : IN(I_X); float* outp = OUTP;
    for (int i = F.tid; i < D; i += NTHR) {
        if (has_prev) { const float wgt = (pk == 1) ? 1.0f : 0.5f, gp = npost[(pl * 3 + pk) * D + i]; cA[i] = wgt * gp * mod[pl * (NMOD * D) + (3 * pk + 2) * D + i]; }
        if (has_next) { const float g = npre[(l * 3 + k) * D + i]; cB[i] = g * (1.0f + mod[l * (NMOD * D) + (3 * k + 1) * D + i]); cC[i] = mod[l * (NMOD * D) + (3 * k) * D + i]; }
    }
    __syncthreads();
    const int row0 = ctx ? SEQ : 0, nrows = ctx ? CTX : SEQ;
    _Float16* H = (_Float16*)(F.ws + WS_H); const bf16_t* Y = (const bf16_t*)(F.ws + WS_Y); bf16_t* U = (bf16_t*)(F.ws + WS_U); const bf16_t* PP = (const bf16_t*)(F.ws + WS_P);
    const int nsplit = (pk != 1) ? 11 : 4;
    const bool xl = !ctx && ((volatile LAS unsigned*)(F.lds + MISC_OFF))[19] != 0u && F.G == 256;
    const int rstart = xl ? (F.vcu & 7) * 2048 + (F.vcu >> 3) * NWAVES + F.wave : F.bid * NWAVES + F.wave;
    const int rstep = xl ? 256 : F.G * NWAVES, rend = xl ? (F.vcu & 7) * 2048 + 2048 : nrows;
    f16x4 hN[8]; u32x2 yN[8];
    if (ph != 0 && rstart < rend) {
#pragma unroll
        for (int j = 0; j < 8; ++j) { hN[j] = __builtin_nontemporal_load((const f16x4*)(H + (size_t)(row0 + rstart) * D + 4 * (F.lane + 64 * j))); yN[j] = !ctx ? __builtin_nontemporal_load((const u32x2*)(Y + (size_t)(row0 + rstart) * D + 4 * (F.lane + 64 * j))) : (u32x2){0u, 0u}; } }
    for (int r = rstart; r < rend; r += rstep) {
        const int row = row0 + r;
        f32x4 h[8]; u32x2 yc[8];
        if (ph == 0) {
#pragma unroll
            for (int j = 0; j < 8; ++j) { h[j] = __builtin_nontemporal_load((const f32x4*)(xin + (size_t)r * D + 4 * (F.lane + 64 * j))); yc[j] = (u32x2){0u, 0u}; }
        } else {
#pragma unroll
            for (int j = 0; j < 8; ++j) { h[j] = __builtin_convertvector(hN[j], f32x4); yc[j] = yN[j]; }
            if (r + rstep < rend) { const int rn = row0 + r + rstep;
#pragma unroll
                for (int j = 0; j < 8; ++j) { hN[j] = __builtin_nontemporal_load((const f16x4*)(H + (size_t)rn * D + 4 * (F.lane + 64 * j))); yN[j] = !ctx ? __builtin_nontemporal_load((const u32x2*)(Y + (size_t)rn * D + 4 * (F.lane + 64 * j))) : (u32x2){0u, 0u}; } }
        }
        if (has_prev) {
            f32x4 y[8]; float ss = 0.f;
#pragma unroll
            for (int j = 0; j < 8; ++j) {
                if (!ctx) { const u32x2 yr = yc[j]; y[j] = (f32x4){bflo(yr.x), bfhi(yr.x), bflo(yr.y), bfhi(yr.y)}; }
                else { u32x2 yr[11];
#pragma unroll
                    for (int sp = 0; sp < 11; ++sp) yr[sp] = (sp < nsplit) ? *(const u32x2*)(PP + ((size_t)sp * 256 + r) * D + 4 * (F.lane + 64 * j)) : (u32x2){0u, 0u};
                    y[j] = (f32x4){0.f, 0.f, 0.f, 0.f};
#pragma unroll
                    for (int sp = 0; sp < 11; ++sp) y[j] += (f32x4){bflo(yr[sp].x), bfhi(yr[sp].x), bflo(yr[sp].y), bfhi(yr[sp].y)}; }
                if (ctx) asm volatile("" ::: "memory");
                ss += (y[j][0] * y[j][0] + y[j][1] * y[j][1]) + (y[j][2] * y[j][2] + y[j][3] * y[j][3]); }
            const float rstd = 1.0f / sqrtf(wave_sum(ss) * (1.0f / D) + NORM_EPS);
#pragma unroll
            for (int j = 0; j < 8; ++j) { const f32x4 cv = *(const LAS f32x4*)(cA + 4 * (F.lane + 64 * j)); h[j] += cv * (y[j] * rstd); }
        }
        if (!has_next) {
#pragma unroll
            for (int j = 0; j < 8; ++j) __builtin_nontemporal_store(h[j], (f32x4*)(outp + (size_t)row * D + 4 * (F.lane + 64 * j)));
            continue;
        }
        float ss2 = 0.f;
#pragma unroll
        for (int j = 0; j < 8; ++j) { __builtin_nontemporal_store(__builtin_convertvector(h[j], f16x4), (f16x4*)(H + (size_t)row * D + 4 * (F.lane + 64 * j))); ss2 += (h[j][0] * h[j][0] + h[j][1] * h[j][1]) + (h[j][2] * h[j][2] + h[j][3] * h[j][3]); }
        const float rstd2 = 1.0f / sqrtf(wave_sum(ss2) * (1.0f / D) + NORM_EPS);
#pragma unroll
        for (int j = 0; j < 8; ++j) { const f32x4 bv = *(const LAS f32x4*)(cB + 4 * (F.lane + 64 * j)), cv = *(const LAS f32x4*)(cC + 4 * (F.lane + 64 * j));
            const f32x4 u = (h[j] * rstd2) * bv + cv; u32x2 w; w.x = cvt_pk_bf16(u[0], u[1]); w.y = cvt_pk_bf16(u[2], u[3]);
            *(u32x2*)(U + (size_t)row * D + 4 * (F.lane + 64 * j)) = w; }
    }
    __syncthreads();
}

__device__ __forceinline__ void sc8(const bf16_t* row, int t0, int len, float w0, float w1, float w2, float b, float (&o)[8]) {
    const u32x4 raw = *(const u32x4*)(row + t0);
    float x[10];
    x[0] = (t0 > 0) ? bf2f(row[t0 - 1]) : 0.f; x[9] = (t0 + 8 < len) ? bf2f(row[t0 + 8]) : 0.f;
#pragma unroll
    for (int e = 0; e < 4; ++e) { x[1 + 2 * e] = bflo(raw[e]); x[2 + 2 * e] = bfhi(raw[e]); }
#pragma unroll
    for (int e = 0; e < 8; ++e) o[e] = x[e] * w0 + x[e + 1] * w1 + x[e + 2] * w2 + b;
}
__device__ __forceinline__ void sc_pair(const bf16_t* row, int t0, int len, float w0, float w1, float w2, float b, float& o0, float& o1) {
    const unsigned pr = *(const unsigned*)(row + t0); const float x0 = bflo(pr), x1 = bfhi(pr);
    const float xm = (t0 > 0) ? bf2f(row[t0 - 1]) : 0.f, xp = (t0 + 2 < len) ? bf2f(row[t0 + 2]) : 0.f;
    o0 = xm * w0 + x0 * w1 + x1 * w2 + b; o1 = x0 * w0 + x1 * w1 + xp * w2 + b;
}
#if defined(DIAG_MASK)
__device__ __forceinline__ void diag_stamp(int cls) {
#ifndef DIAG_BLK
#define DIAG_BLK 0
#endif
    if (blockIdx.x == DIAG_BLK && threadIdx.x == 0) {
        extern __shared__ __attribute__((aligned(16))) unsigned char lds_raw[];
        volatile LAS unsigned long long* ta = (volatile LAS unsigned long long*)((LAS unsigned char*)lds_raw + MISC_OFF + 256);
        const unsigned long long t = __builtin_amdgcn_s_memrealtime();
        if (ta[0] != 0ull) ta[1 + cls] += t - ta[0];
        ta[0] = t;
    }
}
#define STAMP(cls) diag_stamp(cls)
#else
#define STAMP(cls) do { } while (0)
#endif
#if defined(DIAG_MASK) && defined(DIAG_CONV)
#define CSTAMP(cls) diag_stamp(cls)
#else
#define CSTAMP(cls) do { } while (0)
#endif
struct Taps { float a0, a1, a2, ab, b0, b1, b2, bb, v0, v1, v2, vb, skip; };
__device__ __forceinline__ Taps load_taps(const float* wsc, const float* bsc, const float* skp, int hj, int c) {
    Taps t;
    t.a0 = wsc[c]; t.a1 = wsc[3 * D + c]; t.a2 = wsc[6 * D + c]; t.ab = bsc[c];
    t.b0 = wsc[D + c]; t.b1 = wsc[3 * D + D + c]; t.b2 = wsc[6 * D + D + c]; t.bb = bsc[D + c];
    t.v0 = wsc[2 * D + c]; t.v1 = wsc[3 * D + 2 * D + c]; t.v2 = wsc[6 * D + 2 * D + c]; t.vb = bsc[2 * D + c];
    t.skip = skp[hj * D + c];
    return t;
}
__device__ __forceinline__ void hyena_conv_phase(const Frame& F, int hj, int set) {
    using namespace fftc;
    LAS cf* X = (LAS cf*)F.lds;
    for (int c = F.bid; c < D; c += F.G) {
        int tid = F.tid; asm volatile("" : "+v"(tid));
        CSTAMP(21);
        {
            const bf16_t* ZT = (const bf16_t*)(F.ws + WS_ZT);
            const bf16_t* r1 = ZT + (size_t)(D + c) * MT; const bf16_t* r2 = ZT + (size_t)(2 * D + c) * MT;
            const Taps T = load_taps(IN(I_HWSC) + (size_t)hj * 3 * (3 * D), IN(I_HBSC) + (size_t)hj * (3 * D), IN(I_HSKIP), hj, c);
#pragma unroll
            for (int i = 0; i < 4; ++i) {
                const int ch = i * NTHR + tid, t0 = 8 * ch, n0 = 4 * ch;
                float p[8], q[8]; sc8(r1, t0, SEQ, T.b0, T.b1, T.b2, T.bb, p); sc8(r2, t0, SEQ, T.v0, T.v1, T.v2, T.vb, q);
                LAS cf* dst = X + phys(n0);
                dst[0] = (cf){p[0] * q[0], p[1] * q[1]}; dst[1] = (cf){p[2] * q[2], p[3] * q[3]}; dst[2] = (cf){p[4] * q[4], p[5] * q[5]}; dst[3] = (cf){p[6] * q[6], p[7] * q[7]};
            }
        }
        __syncthreads(); CSTAMP(16);
        const bf16_t* fprow = (const bf16_t*)(F.ws + WS_FILT + (size_t)set * 128 * MiB) + (size_t)c * (2 * SEQ);
        const unsigned pf0 = *(const unsigned*)(fprow + 64 * tid), pf1 = 0u;
        unsigned pz0 = 0u, pz1 = 0u;
        if (c + F.G < D) { const bf16_t* zn = (const bf16_t*)(F.ws + WS_ZT) + (size_t)(c + F.G) * MT;
            pz0 = *(const unsigned*)(zn + (size_t)((tid >> 8) * D) * MT + 64 * (tid & 255));
            if (tid < 256) pz1 = *(const unsigned*)(zn + (size_t)(2 * D) * MT + 64 * tid); }
        fft_pass<0, 5, false, NTHR, 1>(X, tid); __syncthreads();
        fft_pass<5, 5, false, NTHR>(X, tid); __syncthreads(); CSTAMP(17);
        asm volatile("" :: "v"(pf0), "v"(pf1), "v"(pz0), "v"(pz1));
        fft_mid(X, tid, (const u32x2*)((const bf16_t*)(F.ws + WS_FILT + (size_t)set * 128 * MiB) + (size_t)c * (2 * SEQ)));
        __syncthreads(); CSTAMP(18);
        fft_pass<5, 5, true, NTHR>(X, tid); __syncthreads();
        fft_pass<0, 5, true, NTHR, 2>(X, tid); __syncthreads(); CSTAMP(19);
        {
            const bf16_t* ZT = (const bf16_t*)(F.ws + WS_ZT); bf16_t* GT = (bf16_t*)(F.ws + WS_GT);
            const bf16_t* r0 = ZT + (size_t)c * MT; const bf16_t* r1 = ZT + (size_t)(D + c) * MT; const bf16_t* r2 = ZT + (size_t)(2 * D + c) * MT;
            const Taps T = load_taps(IN(I_HWSC) + (size_t)hj * 3 * (3 * D), IN(I_HBSC) + (size_t)hj * (3 * D), IN(I_HSKIP), hj, c);
#pragma unroll 2
            for (int i = 0; i < 4; ++i) {
                const int ch = i * NTHR + tid, t0 = 8 * ch, n0 = 4 * ch;
                const LAS cf* src = X + phys(n0);
                const cf s0 = src[0], s1 = src[1], s2 = src[2], s3 = src[3];
                const f32x4 y0 = (f32x4){s0.x, s0.y, s1.x, s1.y}, y1 = (f32x4){s2.x, s2.y, s3.x, s3.y};
                float x0c[8], p[8], q[8]; sc8(r0, t0, SEQ, T.a0, T.a1, T.a2, T.ab, x0c); sc8(r1, t0, SEQ, T.b0, T.b1, T.b2, T.bb, p); sc8(r2, t0, SEQ, T.v0, T.v1, T.v2, T.vb, q);
                u32x4 o;
                o.x = cvt_pk_bf16(x0c[0] * (y0[0] + p[0] * q[0] * T.skip), x0c[1] * (y0[1] + p[1] * q[1] * T.skip));
                o.y = cvt_pk_bf16(x0c[2] * (y0[2] + p[2] * q[2] * T.skip), x0c[3] * (y0[3] + p[3] * q[3] * T.skip));
                o.z = cvt_pk_bf16(x0c[4] * (y1[0] + p[4] * q[4] * T.skip), x0c[5] * (y1[1] + p[5] * q[5] * T.skip));
                o.w = cvt_pk_bf16(x0c[6] * (y1[2] + p[6] * q[6] * T.skip), x0c[7] * (y1[3] + p[7] * q[7] * T.skip));
                *(u32x4*)(GT + (size_t)c * MT + t0) = o;
            }
        }
        __syncthreads(); CSTAMP(20);
    }
}
__device__ __forceinline__ void hyena_conv_ctx(const Frame& F, int hj) {
    const bf16_t* ZT = (const bf16_t*)(F.ws + WS_ZT); bf16_t* GT = (bf16_t*)(F.ws + WS_GT);
    const int qd = F.tid >> 7, t = F.tid & 127;
    LAS float* wb = (LAS float*)F.lds + qd * (3 * CTX); LAS float* fb = wb + CTX;
    for (int c4 = F.bid; c4 < D / 4; c4 += F.G) {
        const int c = 4 * c4 + qd;
        const bf16_t* r0 = ZT + (size_t)c * MT + SEQ; const bf16_t* r1 = ZT + (size_t)(D + c) * MT + SEQ; const bf16_t* r2 = ZT + (size_t)(2 * D + c) * MT + SEQ;
        const Taps T = load_taps(IN(I_HWSC) + (size_t)hj * 3 * (3 * D), IN(I_HBSC) + (size_t)hj * (3 * D), IN(I_HSKIP), hj, c);
        const float* fc = (const float*)(F.ws + WS_FILTC) + (size_t)c * (2 * CTX);
        float wv[2], x0c[2];
#pragma unroll
        for (int o = 0; o < 2; ++o) { const int to = t + 128 * o, te = to & ~1; float p0, p1, q0, q1, xa, xb;
            sc_pair(r1, te, CTX, T.b0, T.b1, T.b2, T.bb, p0, p1); sc_pair(r2, te, CTX, T.v0, T.v1, T.v2, T.vb, q0, q1); sc_pair(r0, te, CTX, T.a0, T.a1, T.a2, T.ab, xa, xb);
            wv[o] = (to & 1) ? p1 * q1 : p0 * q0; x0c[o] = (to & 1) ? xb : xa; wb[to] = wv[o]; }
#pragma unroll
        for (int o = 0; o < 4; ++o) fb[t + 128 * o] = fc[t + 128 * o];
        __syncthreads();
        float a0[8], a1[8];
#pragma unroll
        for (int e = 0; e < 8; ++e) { a0[e] = 0.f; a1[e] = 0.f; }
        for (int s2 = 0; s2 < CTX; s2 += 8) {
#pragma unroll
            for (int e = 0; e < 8; ++e) { const float w = wb[s2 + e]; a0[e] += fb[(t - s2 - e) & (2 * CTX - 1)] * w; a1[e] += fb[(t + 128 - s2 - e) & (2 * CTX - 1)] * w; } }
        const float acc0 = ((a0[0] + a0[1]) + (a0[2] + a0[3])) + ((a0[4] + a0[5]) + (a0[6] + a0[7]));
        const float acc1 = ((a1[0] + a1[1]) + (a1[2] + a1[3])) + ((a1[4] + a1[5]) + (a1[6] + a1[7]));
        GT[(size_t)c * MT + SEQ + t] = f2bf(x0c[0] * (acc0 + wv[0] * T.skip));
        GT[(size_t)c * MT + SEQ + t + 128] = f2bf(x0c[1] * (acc1 + wv[1] * T.skip));
        __syncthreads();
    }
}

__device__ __forceinline__ void transpose_phase(const Frame& F, int trow0, int nrows) {
    LAS bf16_t* tile = (LAS bf16_t*)(F.lds + F.wave * 8704);
    const bf16_t* GT = (const bf16_t*)(F.ws + WS_GT); bf16_t* U = (bf16_t*)(F.ws + WS_U);
    const int ntt = nrows / 64, ntiles = (D / 64) * ntt;
    const int rl = F.lane >> 4, cc = (F.lane & 15) * 4, stride = F.G * NWAVES;
    int it = F.bid * NWAVES + F.wave;
    u32x2 v[16];
    if (it < ntiles) { const int c0 = (it / ntt) * 64, t0 = trow0 + (it % ntt) * 64;
#pragma unroll
        for (int i = 0; i < 16; ++i) v[i] = __builtin_nontemporal_load((const u32x2*)(GT + (size_t)(c0 + 4 * i + rl) * MT + t0 + cc)); }
    for (; it < ntiles; it += stride) {
        const int c0 = (it / ntt) * 64, t0 = trow0 + (it % ntt) * 64;
#pragma unroll
        for (int i = 0; i < 16; ++i) { const int r = 4 * i + rl;
            tile[r * 66 + cc] = (bf16_t)(v[i].x & 0xffff); tile[r * 66 + cc + 1] = (bf16_t)(v[i].x >> 16); tile[r * 66 + cc + 2] = (bf16_t)(v[i].y & 0xffff); tile[r * 66 + cc + 3] = (bf16_t)(v[i].y >> 16); }
        LDS_WAIT(); __builtin_amdgcn_wave_barrier();
        const int nx = it + stride;
        if (nx < ntiles) { const int c1 = (nx / ntt) * 64, t1 = trow0 + (nx % ntt) * 64;
#pragma unroll
            for (int i = 0; i < 16; ++i) v[i] = __builtin_nontemporal_load((const u32x2*)(GT + (size_t)(c1 + 4 * i + rl) * MT + t1 + cc)); }
#pragma unroll 4
        for (int i = 0; i < 16; ++i) { const int t = 4 * i + rl;
            const unsigned e0 = tile[(cc + 0) * 66 + t], e1 = tile[(cc + 1) * 66 + t], e2 = tile[(cc + 2) * 66 + t], e3 = tile[(cc + 3) * 66 + t];
            u32x2 w; w.x = e0 | (e1 << 16); w.y = e2 | (e3 << 16);
            *(u32x2*)(U + (size_t)(t0 + t) * D + c0 + cc) = w; }
        LDS_WAIT(); __builtin_amdgcn_wave_barrier();
    }
}

typedef short s16x4 __attribute__((ext_vector_type(4)));
__device__ __forceinline__ void attn_phase(const Frame& F) {
    constexpr int KP = 288;
    LAS unsigned char* Ks = F.lds; LAS unsigned char* Vs = F.lds + 64 * KP;
    const bf16_t* QKV = (const bf16_t*)(F.ws + WS_ZT); bf16_t* O = (bf16_t*)(F.ws + WS_U); const bf16_t* KVC = (const bf16_t*)(F.ws + WS_KVC);
    const int fr = F.lane & 15, fq = F.lane >> 4; const float* sinkp = IN(I_ASINK);
    for (int unit = F.bid; unit < (SEQ / 128) * 16; unit += F.G) {
        const int qb = unit >> 4, h = unit & 15, kvh = h >> 2, q0 = qb * 128 + 16 * F.wave;
        bf16x8 Qf[4];
#pragma unroll
        for (int ks = 0; ks < 4; ++ks) Qf[ks] = *(const bf16x8*)(QKV + (size_t)(q0 + fr) * QKVD + h * 128 + 32 * ks + 8 * fq);
        float m = sinkp[h] * 1.4426950408889634f;
        float lpart = (fq == 0) ? 1.0f : 0.0f;
        f32x4 Oacc[8];
#pragma unroll
        for (int dt = 0; dt < 8; ++dt) Oacc[dt] = (f32x4){0.f, 0.f, 0.f, 0.f};
        const int ti_first = (qb == 0) ? 2 : 0, nloc = ((qb == SEQ / 128 - 1) ? 4 : 6) - ti_first, nslot = nloc + 4;
        const int lr = F.tid >> 4, lch = F.tid & 15;
        u32x4 pk[2], pv[2];
        { const int krow0 = (qb - 1) * 128 + 64 * ti_first;
#pragma unroll
          for (int hh = 0; hh < 2; ++hh) { const bf16_t* src = QKV + (size_t)(krow0 + lr + 32 * hh) * QKVD + kvh * 128 + lch * 8; pk[hh] = *(const u32x4*)(src + 2048); pv[hh] = *(const u32x4*)(src + 2560); } }
        for (int sl = 0; sl < nslot; ++sl) {
            const bool is_ctx = sl >= nloc;
            const int krow0 = is_ctx ? SEQ + 64 * (sl - nloc) : (qb - 1) * 128 + 64 * (ti_first + sl);
            __syncthreads();
#pragma unroll
            for (int hh = 0; hh < 2; ++hh) { *(LAS u32x4*)(Ks + (lr + 32 * hh) * KP + lch * 16) = pk[hh]; *(LAS u32x4*)(Vs + (lr + 32 * hh) * KP + lch * 16) = pv[hh]; }
            __syncthreads();
            if (sl + 1 < nslot) { const int s2 = sl + 1;
                if (s2 >= nloc) {
#pragma unroll
                    for (int hh = 0; hh < 2; ++hh) { const bf16_t* src = KVC + (size_t)(64 * (s2 - nloc) + lr + 32 * hh) * 1024 + kvh * 128 + lch * 8; pk[hh] = *(const u32x4*)src; pv[hh] = *(const u32x4*)(src + 512); }
                } else { const int kn = (qb - 1) * 128 + 64 * (ti_first + s2);
#pragma unroll
                    for (int hh = 0; hh < 2; ++hh) { const bf16_t* src = QKV + (size_t)(kn + lr + 32 * hh) * QKVD + kvh * 128 + lch * 8; pk[hh] = *(const u32x4*)(src + 2048); pv[hh] = *(const u32x4*)(src + 2560); } } }
            const bool active = is_ctx || !(krow0 + 63 < q0 - 128 || krow0 > q0 + 15 + 128);
            if (active) {
                f32x4 st[4];
#pragma unroll
                for (int kt = 0; kt < 4; ++kt) { st[kt] = (f32x4){0.f, 0.f, 0.f, 0.f};
#pragma unroll
                    for (int ks = 0; ks < 4; ++ks) { const bf16x8 kf = *(const LAS bf16x8*)(Ks + (16 * kt + fr) * KP + (32 * ks + 8 * fq) * 2);
                        st[kt] = __builtin_amdgcn_mfma_f32_16x16x32_bf16(kf, Qf[ks], st[kt], 0, 0, 0); } }
                const float cs = 0.08838834764831845f * 1.4426950408889634f;
                float tmax = -INFINITY;
#pragma unroll
                for (int kt = 0; kt < 4; ++kt)
#pragma unroll
                    for (int r = 0; r < 4; ++r) { float v = st[kt][r] * cs;
                        if (!is_ctx) { const int dk = (krow0 + 16 * kt + 4 * fq + r) - (q0 + fr); if (dk > 128 || dk < -128) v = -INFINITY; }
                        st[kt][r] = v; tmax = fmaxf(tmax, v); }
                tmax = fmaxf(tmax, __shfl_xor(tmax, 16)); tmax = fmaxf(tmax, __shfl_xor(tmax, 32));
                const float mn = fmaxf(m, tmax), alpha = __builtin_amdgcn_exp2f(m - mn); m = mn;
                lpart *= alpha;
#pragma unroll
                for (int dt = 0; dt < 8; ++dt) Oacc[dt] *= alpha;
                bf16x8 pf[2];
#pragma unroll
                for (int kk = 0; kk < 2; ++kk) { float p[8];
#pragma unroll
                    for (int j = 0; j < 8; ++j) { p[j] = __builtin_amdgcn_exp2f(st[2 * kk + (j >> 2)][j & 3] - m); lpart += p[j]; }
                    u32x4 w; w.x = cvt_pk_bf16(p[0], p[1]); w.y = cvt_pk_bf16(p[2], p[3]); w.z = cvt_pk_bf16(p[4], p[5]); w.w = cvt_pk_bf16(p[6], p[7]);
                    pf[kk] = __builtin_bit_cast(bf16x8, w); }
#pragma unroll
                for (int kk = 0; kk < 2; ++kk)
#pragma unroll
                    for (int dt = 0; dt < 8; ++dt) {
                        LAS unsigned char* ap = Vs + (32 * kk + 4 * fq + (fr >> 2)) * KP + (16 * dt + 4 * (fr & 3)) * 2;
                        const s16x4 lo = __builtin_amdgcn_ds_read_tr16_b64_v4i16((LAS s16x4*)ap), hi = __builtin_amdgcn_ds_read_tr16_b64_v4i16((LAS s16x4*)(ap + 16 * KP));
                        const bf16x8 vf = {lo[0], lo[1], lo[2], lo[3], hi[0], hi[1], hi[2], hi[3]};
                        Oacc[dt] = __builtin_amdgcn_mfma_f32_16x16x32_bf16(vf, pf[kk], Oacc[dt], 0, 0, 0);
                    }
            }
        }
        float lsum = lpart; lsum += __shfl_xor(lsum, 16); lsum += __shfl_xor(lsum, 32);
        const float inv = 1.0f / lsum;
#pragma unroll
        for (int dt = 0; dt < 8; ++dt) { const f32x4 o = Oacc[dt] * inv; u32x2 w; w.x = cvt_pk_bf16(o[0], o[1]); w.y = cvt_pk_bf16(o[2], o[3]);
            *(u32x2*)(O + (size_t)(q0 + fr) * D + h * 128 + 16 * dt + 4 * fq) = w; }
    }
    __syncthreads();
}

__device__ __forceinline__ void pool_phase(const Frame& F) {
    const bf16_t* U = (const bf16_t*)(F.ws + WS_U); bf16_t* P = (bf16_t*)(F.ws + WS_GT);
    const int col = (F.tid & 255) * 8, g = col >> 9, size = 2 << g, hs = size >> 1;
    for (int rb = F.bid; rb < SEQ / 64; rb += F.G) {
        const int t0 = rb * 64 + (F.tid >> 8) * 32;
        float s[8];
#pragma unroll
        for (int e = 0; e < 8; ++e) s[e] = 0.f;
        { int lo = t0 - hs, hi = t0 + hs - 1; lo = lo < 0 ? 0 : lo; hi = hi > SEQ ? SEQ : hi;
          for (int r = lo; r < hi; ++r) { const u32x4 v = *(const u32x4*)(U + (size_t)r * D + col);
#pragma unroll
              for (int e = 0; e < 4; ++e) { s[2 * e] += bflo(v[e]); s[2 * e + 1] += bfhi(v[e]); } } }
#pragma unroll 1
        for (int tb = t0; tb < t0 + 32; tb += 8) {
            u32x4 va[8], vs[8], vc[8];
#pragma unroll
            for (int k = 0; k < 8; ++k) { const int t = tb + k; int ra = t + hs - 1; ra = ra < SEQ ? ra : SEQ - 1; int rs = t - hs - 1; rs = rs < 0 ? 0 : rs;
                va[k] = *(const u32x4*)(U + (size_t)ra * D + col); vs[k] = *(const u32x4*)(U + (size_t)rs * D + col); vc[k] = *(const u32x4*)(U + (size_t)t * D + col); }
#pragma unroll
            for (int k = 0; k < 8; ++k) { const int t = tb + k;
                const float ma = (t + hs - 1 < SEQ) ? 1.0f : 0.0f, ms = (t - hs - 1 >= 0 && t > t0) ? 1.0f : 0.0f;
#pragma unroll
                for (int e = 0; e < 4; ++e) { s[2 * e] += ma * bflo(va[k][e]); s[2 * e + 1] += ma * bfhi(va[k][e]); }
#pragma unroll
                for (int e = 0; e < 4; ++e) { s[2 * e] -= ms * bflo(vs[k][e]); s[2 * e + 1] -= ms * bfhi(vs[k][e]); }
                int lo = t - hs, hi = t + hs; lo = lo < 0 ? 0 : lo; hi = hi > SEQ ? SEQ : hi;
                const float invn = 1.0f / (float)(hi - lo);
                u32x4 o;
#pragma unroll
                for (int e = 0; e < 4; ++e) o[e] = cvt_pk_bf16(s[2 * e] * invn - bflo(vc[k][e]), s[2 * e + 1] * invn - bfhi(vc[k][e]));
                *(u32x4*)(P + (size_t)t * D + col) = o;
            }
        }
    }
}

__global__ void __launch_bounds__(NTHR, 2) fwd_kernel(Args a_unused) {
    (void)a_unused;
    {
        Frame F = mk_frame();
        volatile LAS unsigned* MISC = (volatile LAS unsigned*)(F.lds + MISC_OFF);
        for (int u = F.tid; u < (LDS_BYTES - MISC_OFF) / 4; u += NTHR) MISC[u] = 0u;
        __syncthreads();
    }
    XcdBarrier bar;
    { Frame F = mk_frame(); bar = xcd_barrier_post((unsigned*)(F.ws + WS_CTL) + CW_BAR, (volatile LAS unsigned*)(F.lds + MISC_OFF) + 8);
      if (F.tid == 0) { const unsigned x = xb_xcc_id(); const unsigned r = xb_add((unsigned*)(F.ws + WS_CTL) + CW_XRANK + 64 * x, 1u);
          volatile LAS unsigned* M = (volatile LAS unsigned*)(F.lds + MISC_OFF); M[16] = x; M[17] = r; } }
#define GRID_BAR() xcd_barrier(bar)
    unsigned lgen = 0u;
#define LOCAL_BAR() do { volatile LAS unsigned* M_ = (volatile LAS unsigned*)((LAS unsigned char*)lds_dyn() + MISC_OFF); \
        if (M_[19] != 0u && gridDim.x == 256) xcc_local_barrier((unsigned*)(WSP + WS_CTL) + CW_LBAR + 64 * M_[16], 32u, lgen); else xcd_barrier(bar); } while (0)
    STAMP(31);

    { Frame F = mk_frame(); p0_mods(F); }
    { Frame F = mk_frame(); p0_rope(F); }
    { Frame F = mk_frame(); p0_hidden(F, F.wave, 8, 2, 3); }
    GRID_BAR(); STAMP(0);
    { Frame F = mk_frame();
      if (F.tid == 0) { volatile LAS unsigned* M = (volatile LAS unsigned*)(F.lds + MISC_OFF); bool uniform = (F.G % 8) == 0;
#if defined(FORCE_NONUNIFORM)
          uniform = false;
#endif
          for (int j = 0; j < 16; ++j) { const unsigned cnt = xb_ld((unsigned*)(F.ws + WS_CTL) + CW_XRANK + 64 * j); if (j < 8 ? cnt != (unsigned)(F.G / 8) : cnt != 0u) uniform = false; }
          M[18] = uniform ? (M[16] + 8u * M[17]) : (unsigned)F.bid; M[19] = uniform ? 1u : 0u; }
      __syncthreads(); }
    if (__builtin_amdgcn_readfirstlane(threadIdx.x >> 6) < 4) { Frame F = mk_frame(); p0_convert(F, F.wave, 4, 0); }
    else { { Frame F = mk_frame(); p0_filter_td<true>(F, F.wave - 4, 4, 1024, 1152); } { Frame F = mk_frame(); p0_hidden(F, F.wave - 4, 4, 0, 2); } }
    GRID_BAR(); STAMP(1);

    constexpr int NC = 44;
    const int nmain = (int)gridDim.x - NC;
    if ((int)blockIdx.x >= nmain) {
        unsigned sgen = 0u; unsigned* const sbar = (unsigned*)(WSP + WS_CTL) + CW_SUBBAR;
#define CTX_BAR() do { sub_barrier(sbar, (unsigned)NC, sgen); STAMP(30); } while (0)
#define CTX_FRAME() mk_frame_group(nmain, NC)
#define CTX_G1(fi) do { Frame F = CTX_FRAME(); \
        pg8::Gemm g{(const bf16_t*)(F.ws + WS_U) + (size_t)SEQ * D, (const bf16_t*)(F.ws + WS_WIN) + (size_t)(fi) * 2 * DFF * D, CTX, 2 * DFF, D, D, D, 0, 0, 0, 0}; \
        pg8::StaticOrder S; S.init(g.M, g.N, F.G, F.vcu); pg8::EpiSwiGLU E{(bf16_t*)(F.ws + WS_ACT) + (size_t)SEQ * DFFP, DFFP}; \
        pg8::gemm_phase<pg8::EpiSwiGLU>(F.lds, g, S, E); } while (0)
#define CTX_G2(fi) do { Frame F = CTX_FRAME(); \
        pg8::Gemm g{(const bf16_t*)(F.ws + WS_ACT) + (size_t)SEQ * DFFP, (const bf16_t*)(F.ws + WS_WOUT) + (size_t)(fi) * WOUT_STRIDE, 11 * 256, D, 512, DFFP, DFFP, 0, 0, 1024, 1024}; \
        pg8::StaticOrder S; S.init(g.M, g.N, F.G, F.vcu); pg8::EpiBf16 E{(bf16_t*)(F.ws + WS_P), D, nullptr, nullptr, nullptr, nullptr}; \
        pg8::gemm_phase<pg8::EpiBf16>(F.lds, g, S, E); } while (0)
        { Frame F = CTX_FRAME(); thin_phase(F, 0, true); } STAMP(27); CTX_BAR();
        CTX_G1(0); STAMP(26); CTX_BAR(); CTX_G2(0); STAMP(26); CTX_BAR();
        { Frame F = CTX_FRAME(); thin_phase(F, 1, true); } STAMP(27); CTX_BAR();
        { Frame F = CTX_FRAME();
          pg8::Gemm g{(const bf16_t*)(F.ws + WS_WHIN), (const bf16_t*)(F.ws + WS_U) + (size_t)SEQ * D, 3 * D, CTX, D, D, D, 0, 0, 0, 0};
          pg8::StaticOrder S; S.init(g.M, g.N, F.G, F.vcu); pg8::EpiBf16 E{(bf16_t*)(F.ws + WS_ZT) + SEQ, MT, nullptr, IN(I_HBIN), nullptr, nullptr};
          pg8::gemm_phase<pg8::EpiBf16>(F.lds, g, S, E); }
        STAMP(26); CTX_BAR();
        { Frame F = CTX_FRAME(); hyena_conv_ctx(F, 0); } STAMP(27); CTX_BAR();
        { Frame F = CTX_FRAME(); transpose_phase(F, SEQ, CTX); } STAMP(27); CTX_BAR();
        { Frame F = CTX_FRAME();
          pg8::Gemm g{(const bf16_t*)(F.ws + WS_U) + (size_t)SEQ * D, (const bf16_t*)(F.ws + WS_WHOUT), 4 * 256, D, 512, D, D, 0, 0, 1024, 1024};
          pg8::StaticOrder S; S.init(g.M, g.N, F.G, F.vcu); pg8::EpiBf16 E{(bf16_t*)(F.ws + WS_P), D, (const float*)(F.ws + WS_BQP) + QKVD, nullptr, nullptr, nullptr};
          pg8::gemm_phase<pg8::EpiBf16>(F.lds, g, S, E); }
        STAMP(26); CTX_BAR();
        { Frame F = CTX_FRAME(); thin_phase(F, 2, true); } STAMP(27); CTX_BAR();
        CTX_G1(1); STAMP(26); CTX_BAR(); CTX_G2(1); STAMP(26); CTX_BAR();
        { Frame F = CTX_FRAME(); thin_phase(F, 3, true); } STAMP(27); CTX_BAR();
        CTX_G1(2); STAMP(26); CTX_BAR(); CTX_G2(2); STAMP(26); CTX_BAR();
        { Frame F = CTX_FRAME(); thin_phase(F, 4, true); } STAMP(27); CTX_BAR();
        { Frame F = CTX_FRAME();
          pg8::Gemm g{(const bf16_t*)(F.ws + WS_U) + (size_t)SEQ * D, (const bf16_t*)(F.ws + WS_WQKV) + (size_t)2048 * D, CTX, 1024, D, D, D, 0, 0, 0, 0};
          pg8::StaticOrder S; S.init(g.M, g.N, F.G, F.vcu); pg8::EpiBf16 E{(bf16_t*)(F.ws + WS_KVC), 1024, (const float*)(F.ws + WS_BQP) + 2048, nullptr, nullptr, nullptr};
          pg8::gemm_phase<pg8::EpiBf16>(F.lds, g, S, E); }
    } else {
        unsigned mgen = 0u; unsigned* const mbar = (unsigned*)(WSP + WS_CTL) + CW_SUBBAR + 64;
        if (__builtin_amdgcn_readfirstlane(threadIdx.x >> 6) < 3) { Frame F = mk_frame_group(0, nmain); p0_convert(F, F.wave, 3, 1); }
        else { Frame F = mk_frame_group(0, nmain); p0_filter_td<false>(F, F.wave - 3, 5, 0, 1024); }
        sub_barrier(mbar, (unsigned)nmain, mgen); STAMP(28);
        { Frame F = mk_frame_group(0, nmain); p0_filter_fft(F); __syncthreads(); }
        STAMP(2);
        { Frame F = mk_frame_group(0, nmain); thin_phase(F, 0, false); }
    }
    GRID_BAR(); STAMP(29);

    for (int ph = 0; ph < 12; ++ph) {
        if (ph > 0) {
        { Frame F = mk_frame(); thin_phase(F, ph, false); }
        if (ph % 3 != 1) LOCAL_BAR(); else GRID_BAR();
        }
        STAMP(3);
        const int l = ph / 3, k = ph % 3, kind = l % 3, mj = l / 3;
        if (k != 1) {
            const int fi = l * 2 + (k >> 1);
            { Frame F = mk_frame();
              pg8::Gemm g{(const bf16_t*)(F.ws + WS_U), (const bf16_t*)(F.ws + WS_WIN) + (size_t)fi * 2 * DFF * D, SEQ, 2 * DFF, D, D, D, 0, 0, 0, 0};
              pg8::StaticOrder S; S.init(g.M, g.N, F.G, F.vcu);
              pg8::EpiSwiGLU E{(bf16_t*)(F.ws + WS_ACT), DFFP};
              pg8::gemm_phase<pg8::EpiSwiGLU>(F.lds, g, S, E, 22); }
            LOCAL_BAR(); STAMP(4);
        } else {
            if (kind != 2) {
                Frame F = mk_frame();
                pg8::Gemm g; pg8::EpiBf16 E;
                if (kind == 0) { g = pg8::Gemm{(const bf16_t*)(F.ws + WS_WHIN) + (size_t)mj * 3 * D * D, (const bf16_t*)(F.ws + WS_U), 3 * D, SEQ, D, D, D, 0, 0, 0, 0};
                    E = pg8::EpiBf16{(bf16_t*)(F.ws + WS_ZT), MT, nullptr, IN(I_HBIN) + (size_t)mj * 3 * D, nullptr, nullptr}; }
                else { g = pg8::Gemm{(const bf16_t*)(F.ws + WS_U), (const bf16_t*)(F.ws + WS_WQKV), SEQ, QKVD, D, D, D, 0, 0, 0, 0};
                    E = pg8::EpiBf16{(bf16_t*)(F.ws + WS_ZT), QKVD, (const float*)(F.ws + WS_BQP), nullptr, nullptr, (const f32x2*)(F.ws + WS_ROPE)}; }
                pg8::StaticOrder S; S.init(g.M, g.N, F.G, F.vcu);
                pg8::gemm_phase<pg8::EpiBf16>(F.lds, g, S, E);
            }
            if (kind != 2) { GRID_BAR(); STAMP(kind == 0 ? 6 : 10); }
            if (kind == 0) {
                { Frame F = mk_frame(); hyena_conv_phase(F, mj, mj); }
                GRID_BAR(); STAMP(7);
                { Frame F = mk_frame(); transpose_phase(F, 0, SEQ); }
                GRID_BAR(); STAMP(8);
            } else if (kind == 1) {
                { Frame F = mk_frame(); attn_phase(F); }
                GRID_BAR(); STAMP(12);
            } else {
                { Frame F = mk_frame(); pool_phase(F); }
                GRID_BAR(); STAMP(14);
            }
        }
        { Frame F = mk_frame();
          pg8::Gemm gF; pg8::EpiBf16 eF;
          if (k != 1) { const int fi = l * 2 + (k >> 1);
              gF = pg8::Gemm{(const bf16_t*)(F.ws + WS_ACT), (const bf16_t*)(F.ws + WS_WOUT) + (size_t)fi * WOUT_STRIDE, SEQ, D, DFF, DFFP, DFFP, 0, 0, 0, 0};
              eF = pg8::EpiBf16{(bf16_t*)(F.ws + WS_Y), D, nullptr, nullptr, nullptr, nullptr}; }
          else if (kind == 0) { gF = pg8::Gemm{(const bf16_t*)(F.ws + WS_U), (const bf16_t*)(F.ws + WS_WHOUT) + (size_t)mj * D * D, SEQ, D, D, D, D, 0, 0, 0, 0};
              eF = pg8::EpiBf16{(bf16_t*)(F.ws + WS_Y), D, IN(I_HBOUT) + (size_t)mj * D, nullptr, nullptr, nullptr}; }
          else if (kind == 1) { gF = pg8::Gemm{(const bf16_t*)(F.ws + WS_U), (const bf16_t*)(F.ws + WS_WO), SEQ, D, D, D, D, 0, 0, 0, 0};
              eF = pg8::EpiBf16{(bf16_t*)(F.ws + WS_Y), D, IN(I_ABO), nullptr, nullptr, nullptr}; }
          else { gF = pg8::Gemm{(const bf16_t*)(F.ws + WS_GT), (const bf16_t*)(F.ws + WS_WP), SEQ, D, 512, D, 512, 1, 512, 0, 0};
              eF = pg8::EpiBf16{(bf16_t*)(F.ws + WS_Y), D, IN(I_PB), nullptr, IN(I_PSCALE), nullptr}; }
          pg8::StaticOrder S; S.init(gF.M, gF.N, F.G, F.vcu);
          pg8::gemm_phase<pg8::EpiBf16>(F.lds, gF, S, eF, (k != 1) ? 24 : -1);
        }
        LOCAL_BAR(); STAMP(k != 1 ? 5 : (kind == 0 ? 9 : (kind == 1 ? 13 : 15)));
    }
    { Frame F = mk_frame(); thin_phase(F, 12, false); }
    STAMP(3);
#if defined(DIAG_MASK)
    if (blockIdx.x == DIAG_BLK && threadIdx.x == 0) {
        extern __shared__ __attribute__((aligned(16))) unsigned char lds_raw[];
        volatile LAS unsigned long long* ta = (volatile LAS unsigned long long*)((LAS unsigned char*)lds_raw + MISC_OFF + 256);
        unsigned long long tot = 0ull;
        for (int c = 0; c < 32; ++c) if (((unsigned long long)(DIAG_MASK) >> c) & 1ull) tot += ta[1 + c];
        OUTP[(size_t)(DIAG_BLK * 8) * D] += (float)tot * 0.0001f;
    }
#endif
}

static_assert(offsetof(Args, out) == 8 * 33 && offsetof(Args, ws) == 8 * 34 && offsetof(Args, invf) == 8 * 35 && sizeof(Args) == 8 * 67, "kernarg layout");
extern "C" void kernel_launch(void* const* d_in, const int* in_sizes, int n_in, void* d_out, int out_size, void* d_ws, size_t ws_size, hipStream_t stream) {
    static int grid = 0;
    if (grid == 0) {
        if (n_in != 33 || out_size != SEQ * D || ws_size < WS_END) { fprintf(stderr, "kernel_launch: unexpected problem: n_in %d out %d ws %zu (need %zu)\n", n_in, out_size, ws_size, (size_t)WS_END); grid = -1; return; }
        int dev = 0, cus = 0, per_cu = 0;
        if (hipGetDevice(&dev) != hipSuccess || hipDeviceGetAttribute(&cus, hipDeviceAttributeMultiprocessorCount, dev) != hipSuccess) { grid = -1; return; }
        if (hipFuncSetAttribute((const void*)fwd_kernel, hipFuncAttributeMaxDynamicSharedMemorySize, LDS_BYTES) != hipSuccess) { fprintf(stderr, "kernel_launch: hipFuncSetAttribute failed\n"); grid = -1; return; }
        if (hipOccupancyMaxActiveBlocksPerMultiprocessor(&per_cu, (const void*)fwd_kernel, NTHR, LDS_BYTES) != hipSuccess || per_cu < 1) fprintf(stderr, "kernel_launch: occupancy query says %d\n", per_cu);
        (void)hipGetLastError();
        grid = cus;
    }
    if (grid < 0) return;
    (void)in_sizes;
    if (hipMemsetAsync((char*)d_ws + WS_CTL, 0, CTL_ZERO_BYTES, stream) != hipSuccess) { fprintf(stderr, "kernel_launch: memset failed\n"); return; }
    Args a{};
    for (int i = 0; i < 33; ++i) a.in[i] = (const float*)d_in[i];
    a.out = (float*)d_out; a.ws = (unsigned char*)d_ws;
    for (int j = 0; j < 32; ++j) a.invf[j] = std::pow(10000.0, -(double)j / 32.0);
    hipLaunchKernelGGL(fwd_kernel, dim3(grid), dim3(NTHR), LDS_BYTES, stream, a);
    const hipError_t le = hipPeekAtLastError();
    if (le != hipSuccess) fprintf(stderr, "kernel_launch: launch failed: %s\n", hipGetErrorName(le));
}
```

```cpp
#include <hip/hip_runtime.h>
#include <cstdio>
#include <cstdint>
#include <cmath>
#include <cstddef>

#define LAS __attribute__((address_space(3)))
#define GAS __attribute__((address_space(1)))
#define CAS __attribute__((address_space(4)))
typedef unsigned short bf16_t;
typedef short bf16x8 __attribute__((ext_vector_type(8)));
typedef float f32x4 __attribute__((ext_vector_type(4)));
typedef float f32x2 __attribute__((ext_vector_type(2)));
typedef unsigned u32x4 __attribute__((ext_vector_type(4)));
typedef unsigned u32x2 __attribute__((ext_vector_type(2)));
typedef _Float16 f16x4 __attribute__((ext_vector_type(4)));

constexpr int D = 2048, SEQ = 16384, CTX = 256, MT = SEQ + CTX, DEPTH = 4, DFF = 5632, NMOD = 9, QKVD = 3072;
constexpr int DFFP = DFF + 64;
constexpr int NWAVES = 8, NTHR = 512;
constexpr float NORM_EPS = 1e-6f;

constexpr size_t MiB = 1u << 20;
constexpr size_t WS_CTL = 0, CTL_ZERO_BYTES = 32 * 1024;
constexpr size_t WS_MOD = 1 * MiB;
constexpr size_t WS_ROPE = 2 * MiB;
constexpr size_t WS_HID = 3 * MiB;
constexpr size_t WS_FILTC = 15 * MiB;
constexpr size_t WS_FILT = 19 * MiB;
constexpr size_t WS_WIN = WS_FILT + 512 * MiB;
constexpr size_t WS_WOUT = WS_WIN + 352 * MiB;
constexpr size_t WOUT_STRIDE = 23 * MiB / 2;
constexpr size_t WS_WHIN = WS_WOUT + 184 * MiB;
constexpr size_t WS_WHOUT = WS_WHIN + 48 * MiB;
constexpr size_t WS_WQKV = WS_WHOUT + 16 * MiB;
constexpr size_t WS_WO = WS_WQKV + 12 * MiB;
constexpr size_t WS_WP = WS_WO + 8 * MiB;
constexpr size_t WS_H = WS_WP + 2 * MiB;
constexpr size_t WS_U = WS_H + 130 * MiB;
constexpr size_t WS_ACT = WS_U + 65 * MiB;
constexpr size_t WS_Y = WS_ACT + 182 * MiB;
constexpr size_t WS_ZT = WS_Y + 130 * MiB;
constexpr size_t WS_GT = WS_ZT + 195 * MiB;
constexpr size_t WS_P = WS_GT + 65 * MiB;
constexpr size_t WS_END = WS_P + 12 * MiB;
constexpr size_t WS_KVC = WS_ROPE + 131072;
constexpr size_t WS_BQP = WS_ROPE + 65536;
constexpr int CW_TMO = 0;
constexpr int CW_BAR = 4096;
constexpr int CW_LBAR = 3072;
constexpr int CW_SUBBAR = 2048;
constexpr int CW_XRANK = 1024;

constexpr int LDS_SCRATCH = 143360;
constexpr int MISC_OFF = LDS_SCRATCH;
constexpr int LDS_BYTES = 151552;

__device__ __forceinline__ unsigned cvt_pk_bf16(float lo, float hi) { unsigned r; asm volatile("v_cvt_pk_bf16_f32 %0, %1, %2" : "=v"(r) : "v"(lo), "v"(hi)); return r; }
__device__ __forceinline__ float bf2f(unsigned short b) { return __uint_as_float(((unsigned)b) << 16); }
__device__ __forceinline__ float bflo(unsigned w) { return __uint_as_float(w << 16); }
__device__ __forceinline__ float bfhi(unsigned w) { return __uint_as_float(w & 0xffff0000u); }
__device__ __forceinline__ bf16_t f2bf(float f) { return (bf16_t)(cvt_pk_bf16(f, 0.f) & 0xffffu); }
__device__ __forceinline__ float wave_sum(float v) {
#pragma unroll
    for (int o = 1; o < 64; o <<= 1) v += __shfl_xor(v, o);
    return v;
}
__device__ __forceinline__ float silu_f(float x) { return x * __builtin_amdgcn_rcpf(1.f + __builtin_amdgcn_exp2f(-1.4426950408889634f * x)); }
#define LDS_WAIT() asm volatile("s_waitcnt lgkmcnt(0)" ::: "memory")
#define VM_WAIT() asm volatile("s_waitcnt vmcnt(0)" ::: "memory")

#if defined(DIAG_MASK) && defined(DIAG_GEMM)
__device__ __forceinline__ void diag_stamp(int cls);
#define GSTAMP(c) do { if ((c) >= 0) diag_stamp(c); } while (0)
#else
#define GSTAMP(c) do { } while (0)
#endif
namespace pg8 {
constexpr int BM = 256, BK = 64, HALF = 128, HTB = HALF * BK * 2, STAGE_BYTES = 8 * HTB, NXCD = 8, WGM = 8;
__host__ __device__ __forceinline__ int lds_byte(int r, int c) { const int st = (r >> 4) * 2 + (c >> 5), rr = r & 15, cc = c & 31, ob = rr * 64 + cc * 2; return st * 1024 + (ob ^ (((ob >> 9) & 1) << 5)); }
__host__ __device__ __forceinline__ void stage_rc(int b, int& R, int& C) { const int st = b / 1024, sb = b % 1024, swz = sb ^ (((sb >> 9) & 1) << 5); R = (st >> 1) * 16 + swz / 64; C = (st & 1) * 32 + (swz % 64) / 2; }
__host__ __device__ __forceinline__ int perm32(int rho) { const int n = rho >> 4, i = rho & 15; return 8 * (i >> 2) + 4 * n + (i & 3); }

struct Unit { int pm, pn; };
struct Gemm { const bf16_t* A; const bf16_t* Bt; int M, N, K, lda, ldb, a_shift, a_step; size_t a_pm, b_pm; };

struct StaticOrder {
    int nM, nN, nwg, G, c;
    __device__ void init(int M, int N, int G_, int c_) { nM = M / BM; nN = N / BM; nwg = nM * nN; G = G_; c = c_; }
    __device__ bool next(int i, Unit& u) const {
        const long L = (long)i * G + c; if (L >= nwg) return false;
        int wgid = (int)L; { const int q = nwg / NXCD, r = nwg % NXCD, xcd = wgid % NXCD, off = wgid / NXCD; wgid = (xcd < r ? xcd * (q + 1) : r * (q + 1) + (xcd - r) * q) + off; }
        const int nig = WGM * nN, gid = wgid / nig, fm = gid * WGM, gsz = (nM - fm) < WGM ? (nM - fm) : WGM;
        u.pm = fm + ((wgid % nig) % gsz); u.pn = (wgid % nig) / gsz; return true;
    }
};

struct EpiSwiGLU {
    static constexpr bool PERM = true;
    bf16_t* O; int ldc;
    __device__ __forceinline__ void operator()(const f32x4 (&acc)[2][2][4][2], const Unit& u, int wr, int wc, int fr, int fq) const {
        const int row0 = u.pm * BM + wr * 64 + fr, col0 = u.pn * HALF + wc * 32 + 8 * fq;
#pragma unroll
        for (int ai = 0; ai < 2; ++ai)
#pragma unroll
            for (int m = 0; m < 4; ++m) { bf16_t* rowp = O + (size_t)(row0 + ai * HALF + m * 16) * ldc + col0;
                const f32x4 g0 = acc[ai][0][m][0], g1 = acc[ai][0][m][1], u0 = acc[ai][1][m][0], u1 = acc[ai][1][m][1];
                u32x4 w;
                w.x = cvt_pk_bf16(silu_f(g0[0]) * u0[0], silu_f(g0[1]) * u0[1]); w.y = cvt_pk_bf16(silu_f(g0[2]) * u0[2], silu_f(g0[3]) * u0[3]);
                w.z = cvt_pk_bf16(silu_f(g1[0]) * u1[0], silu_f(g1[1]) * u1[1]); w.w = cvt_pk_bf16(silu_f(g1[2]) * u1[2], silu_f(g1[3]) * u1[3]);
#if !defined(DIAG_NO_EPI_STORE)
                *(u32x4*)rowp = w;
#else
                if (w.x == 0x12345678u) *(u32x4*)rowp = w;
#endif
                }
    }
};
struct EpiF32 {
    static constexpr bool PERM = false;
    float* C; int ldc; const float* bias; const float* scale;
    __device__ __forceinline__ void operator()(const f32x4 (&acc)[2][2][4][2], const Unit& u, int wr, int wc, int fr, int fq) const {
        const int row0 = u.pm * BM + wr * 64 + fr, col0 = u.pn * BM + wc * 32 + 4 * fq;
        f32x4 bv[2][2], sv[2][2];
#pragma unroll
        for (int bj = 0; bj < 2; ++bj)
#pragma unroll
            for (int n = 0; n < 2; ++n) { bv[bj][n] = bias ? *(const f32x4*)(bias + col0 + bj * HALF + n * 16) : (f32x4){0.f, 0.f, 0.f, 0.f};
                sv[bj][n] = scale ? *(const f32x4*)(scale + col0 + bj * HALF + n * 16) : (f32x4){1.f, 1.f, 1.f, 1.f}; }
#pragma unroll
        for (int ai = 0; ai < 2; ++ai)
#pragma unroll
            for (int m = 0; m < 4; ++m) { float* rowp = C + (size_t)(row0 + ai * HALF + m * 16) * ldc + col0;
#pragma unroll
                for (int bj = 0; bj < 2; ++bj)
#pragma unroll
                    for (int n = 0; n < 2; ++n) *(f32x4*)(rowp + bj * HALF + n * 16) = (acc[ai][bj][m][n] + bv[bj][n]) * sv[bj][n]; }
    }
};
struct EpiBf16 {
    static constexpr bool PERM = true;
    bf16_t* O; int ldc; const float* cbias; const float* rbias; const float* cscale; const f32x2* rope;
    __device__ __forceinline__ void operator()(const f32x4 (&acc)[2][2][4][2], const Unit& u, int wr, int wc, int fr, int fq) const {
        const int row0 = u.pm * BM + wr * 64 + fr, col0 = u.pn * BM + wc * 32 + 8 * fq;
        f32x4 bv[2][2], sv[2][2];
#pragma unroll
        for (int bj = 0; bj < 2; ++bj)
#pragma unroll
            for (int n = 0; n < 2; ++n) { bv[bj][n] = cbias ? *(const f32x4*)(cbias + col0 + bj * HALF + 4 * n) : (f32x4){0.f, 0.f, 0.f, 0.f};
                sv[bj][n] = cscale ? *(const f32x4*)(cscale + col0 + bj * HALF + 4 * n) : (f32x4){1.f, 1.f, 1.f, 1.f}; }
        const bool do_rope = rope != nullptr && u.pn < 10 && u.pm < 64;
#pragma unroll
        for (int ai = 0; ai < 2; ++ai)
#pragma unroll
            for (int m = 0; m < 4; ++m) { const int row = row0 + ai * HALF + m * 16; bf16_t* rowp = O + (size_t)row * ldc + col0; const float rb = rbias ? rbias[row] : 0.f;
#pragma unroll
                for (int bj = 0; bj < 2; ++bj) { f32x4 v0 = (acc[ai][bj][m][0] + bv[bj][0] + rb) * sv[bj][0], v1 = (acc[ai][bj][m][1] + bv[bj][1] + rb) * sv[bj][1];
                    if (do_rope) { const int e0 = (col0 + bj * HALF) & 127, pos = (e0 < 64) ? (row >> 6) : (row & 63);
                        const f32x4* tb = (const f32x4*)(rope + pos * 32 + ((e0 & 63) >> 1)); const f32x4 c0 = tb[0], c1 = tb[1];
                        v0 = (f32x4){v0[0] * c0[0] - v0[1] * c0[1], v0[1] * c0[0] + v0[0] * c0[1], v0[2] * c0[2] - v0[3] * c0[3], v0[3] * c0[2] + v0[2] * c0[3]};
                        v1 = (f32x4){v1[0] * c1[0] - v1[1] * c1[1], v1[1] * c1[0] + v1[0] * c1[1], v1[2] * c1[2] - v1[3] * c1[3], v1[3] * c1[2] + v1[2] * c1[3]}; }
                    u32x4 w; w.x = cvt_pk_bf16(v0[0], v0[1]); w.y = cvt_pk_bf16(v0[2], v0[3]); w.z = cvt_pk_bf16(v1[0], v1[1]); w.w = cvt_pk_bf16(v1[2], v1[3]);
                    *(u32x4*)(rowp + bj * HALF) = w; } }
    }
};

template <class Epi>
__device__ __forceinline__ void gemm_phase(LAS unsigned char* lds, const Gemm g, const StaticOrder& S, const Epi& E, int dcls = -1) {
    int tid_ = threadIdx.x; asm volatile("" : "+v"(tid_));
    const int tid = tid_, wid = __builtin_amdgcn_readfirstlane(tid >> 6), lane = tid & 63, wr = wid >> 2, wc = wid & 3, fr = lane & 15, fq = lane >> 4;
    const int K = g.K, nt = K / BK;
    unsigned voffA[2], voffB[2];
#pragma unroll
    for (int i = 0; i < 2; ++i) { int R, C; stage_rc(tid * 16 + i * 8192, R, C); const int Rb = Epi::PERM ? ((R & ~31) + perm32(R & 31)) : R;
        voffA[i] = (unsigned)(R * g.lda + C) * 2u; voffB[i] = (unsigned)(Rb * g.ldb + C) * 2u; }
    const size_t kstep = (size_t)(BK * 2);
    const size_t hstepA = (size_t)HALF * g.lda * 2, hstepB = (size_t)HALF * g.ldb * 2;
    const size_t tstepA = g.a_pm ? g.a_pm : 2 * hstepA, tstepB = 2 * hstepB;
    const unsigned ldsw = (unsigned)wid * 1024u;
    const int aoff = lds_byte(wr * 64 + fr, fq * 8), boff = lds_byte(wc * 32 + fr, fq * 8);
#define PG8_SA(b, h) (((b) * 2 + (h)) * HTB)
#define PG8_SB(b, h) ((4 + (b) * 2 + (h)) * HTB)
#define PG8_STAGE(bufoff, gbase, voff) do { _Pragma("unroll") for (int _i = 0; _i < 2; ++_i) \
        __builtin_amdgcn_global_load_lds((const unsigned*)((const char*)(gbase) + (voff)[_i]), (LAS unsigned*)(lds + (bufoff) + ldsw + _i * 8192), 16, 0, 0); } while (0)
#define PG8_LDA(dst, b, h) do { _Pragma("unroll") for (int m = 0; m < 4; ++m) _Pragma("unroll") for (int k = 0; k < 2; ++k) dst[m][k] = *(const LAS bf16x8*)(lds + PG8_SA(b, h) + aoff + m * 2048 + k * 1024); } while (0)
#define PG8_LDB(dst, b, h) do { _Pragma("unroll") for (int n = 0; n < 2; ++n) _Pragma("unroll") for (int k = 0; k < 2; ++k) dst[n][k] = *(const LAS bf16x8*)(lds + PG8_SB(b, h) + boff + n * 2048 + k * 1024); } while (0)
#define PG8_MMA(ai, bj, At, Bt) do { __builtin_amdgcn_s_setprio(1); _Pragma("unroll") for (int m = 0; m < 4; ++m) _Pragma("unroll") for (int n = 0; n < 2; ++n) _Pragma("unroll") for (int k = 0; k < 2; ++k) \
        acc[ai][bj][m][n] = __builtin_amdgcn_mfma_f32_16x16x32_bf16(Bt[n][k], At[m][k], acc[ai][bj][m][n], 0, 0, 0); __builtin_amdgcn_s_setprio(0); } while (0)
#define PG8_WAIT_V(n) asm volatile("s_waitcnt vmcnt(" #n ")" ::: "memory")
#define PG8_WAIT_L(n) asm volatile("s_waitcnt lgkmcnt(" #n ")" ::: "memory")
#define PG8_BAR __builtin_amdgcn_s_barrier()
#define PG8_SCHED __builtin_amdgcn_sched_barrier(0)
    Unit cur, nxt; int ui = 0;
    if (!S.next(0, cur)) return;
    f32x4 acc[2][2][4][2];
#pragma unroll
    for (int a = 0; a < 2; ++a)
#pragma unroll
        for (int b = 0; b < 2; ++b)
#pragma unroll
            for (int m = 0; m < 4; ++m)
#pragma unroll
                for (int n = 0; n < 2; ++n) acc[a][b][m][n] = (f32x4){0.f, 0.f, 0.f, 0.f};
    bf16x8 At[4][2], B0[2][2], B1[2][2];
    const char* cA = (const char*)g.A + (size_t)cur.pm * tstepA + (size_t)((cur.pn >> g.a_shift) * g.a_step) * 2; const char* cB = (const char*)g.Bt + (size_t)cur.pn * tstepB + (size_t)cur.pm * g.b_pm;
    PG8_STAGE(PG8_SB(0, 0), cB, voffB); PG8_STAGE(PG8_SB(0, 1), cB + hstepB, voffB); PG8_STAGE(PG8_SA(0, 0), cA, voffA); PG8_STAGE(PG8_SA(0, 1), cA + hstepA, voffA);
    if (wr == 1) PG8_BAR;
    PG8_WAIT_V(2); PG8_BAR;
    PG8_STAGE(PG8_SB(1, 0), cB + kstep, voffB); PG8_STAGE(PG8_SA(1, 0), cA + kstep, voffA); PG8_STAGE(PG8_SB(1, 1), cB + hstepB + kstep, voffB);
    PG8_WAIT_V(6); PG8_BAR;
    for (;;) {
        const bool has_next = S.next(ui + 1, nxt);
        const char* nA = has_next ? (const char*)g.A + (size_t)nxt.pm * tstepA + (size_t)((nxt.pn >> g.a_shift) * g.a_step) * 2 : cA; const char* nB = has_next ? (const char*)g.Bt + (size_t)nxt.pn * tstepB + (size_t)nxt.pm * g.b_pm : cB;
        for (int t = 0; t < nt; t += 2) {
            const bool last = (t == nt - 2);
            const char* a1 = cA + (size_t)(t + 1) * kstep;
            const char* a2 = last ? nA : cA + (size_t)(t + 2) * kstep; const char* b2 = last ? nB : cB + (size_t)(t + 2) * kstep;
            const char* a3 = a2 + kstep; const char* b3 = b2 + kstep;
            PG8_LDB(B0, 0, 0); PG8_LDB(B1, 0, 1); PG8_SCHED; PG8_LDA(At, 0, 0); PG8_STAGE(PG8_SA(1, 1), a1 + hstepA, voffA);
            PG8_WAIT_V(8); PG8_WAIT_L(0); PG8_BAR; PG8_MMA(0, 0, At, B0); PG8_MMA(0, 1, At, B1); PG8_BAR; PG8_SCHED;
            PG8_LDA(At, 0, 1); PG8_STAGE(PG8_SB(0, 0), b2, voffB); PG8_STAGE(PG8_SB(0, 1), b2 + hstepB, voffB); PG8_STAGE(PG8_SA(0, 0), a2, voffA);
            PG8_WAIT_V(8); PG8_WAIT_L(0); PG8_BAR; PG8_MMA(1, 0, At, B0); PG8_MMA(1, 1, At, B1); PG8_BAR; PG8_SCHED;
            PG8_LDB(B0, 1, 0); PG8_LDB(B1, 1, 1); PG8_SCHED; PG8_LDA(At, 1, 0); PG8_STAGE(PG8_SA(0, 1), a2 + hstepA, voffA);
            PG8_WAIT_V(8); PG8_WAIT_L(0); PG8_BAR; PG8_MMA(0, 0, At, B0); PG8_MMA(0, 1, At, B1); PG8_BAR; PG8_SCHED;
            PG8_LDA(At, 1, 1); PG8_STAGE(PG8_SB(1, 0), b3, voffB); PG8_STAGE(PG8_SB(1, 1), b3 + hstepB, voffB); PG8_STAGE(PG8_SA(1, 0), a3, voffA);
            PG8_WAIT_V(8); PG8_WAIT_L(0); PG8_BAR; PG8_MMA(1, 0, At, B0); PG8_MMA(1, 1, At, B1); PG8_BAR; PG8_SCHED;
        }
        if (wr == 0) PG8_BAR;
        GSTAMP(dcls);
        E(acc, cur, wr, wc, fr, fq);
        GSTAMP(dcls >= 0 ? dcls + 1 : -1);
        if (!has_next) break;
#pragma unroll
        for (int a = 0; a < 2; ++a)
#pragma unroll
            for (int b = 0; b < 2; ++b)
#pragma unroll
                for (int m = 0; m < 4; ++m)
#pragma unroll
                    for (int n = 0; n < 2; ++n) acc[a][b][m][n] = (f32x4){0.f, 0.f, 0.f, 0.f};
        cur = nxt; cA = nA; cB = nB; ++ui;
        if (wr == 1) PG8_BAR;
    }
    PG8_WAIT_V(0);
    PG8_BAR;
#undef PG8_SA
#undef PG8_SB
#undef PG8_STAGE
#undef PG8_LDA
#undef PG8_LDB
#undef PG8_MMA
#undef PG8_WAIT_V
#undef PG8_WAIT_L
#undef PG8_BAR
#undef PG8_SCHED
}
}

#define XB_TMO      128
#define XB_XCNT(j)  (256  + 64 * (j))
#define XB_XSUB(j)  (1280 + 64 * (j))
#define XB_XGEN(j)  (2304 + 64 * (j))
#define XB_TOP      3328
#define XB_TOPGEN   3392
#define XCD_BAR_WORDS 3456
#define XB_SPIN_CAP (1u << 18)
__device__ __forceinline__ unsigned xb_ld(unsigned* p)              { return __hip_atomic_load(p, __ATOMIC_RELAXED, __HIP_MEMORY_SCOPE_AGENT); }
__device__ __forceinline__ unsigned xb_add(unsigned* p, unsigned v) { return __hip_atomic_fetch_add(p, v, __ATOMIC_RELAXED, __HIP_MEMORY_SCOPE_AGENT); }
__device__ __forceinline__ unsigned xb_xcc_id() { return (unsigned)__builtin_amdgcn_s_getreg((3 << 11) | 20) & 0xFu; }
#define XB_SPIN(cond, bar) do { unsigned _sp = 0; while (cond) { __builtin_amdgcn_s_sleep(1); \
    if ((++_sp & 255u) == 0u) { if (xb_ld(&(bar)[XB_TMO])) break; if (_sp > XB_SPIN_CAP) { atomicAdd(&(bar)[XB_TMO], 1u); break; } } } } while (0)
struct XcdBarrier { unsigned* bar; unsigned x; volatile LAS unsigned* st; };
__device__ __forceinline__ XcdBarrier xcd_barrier_post(unsigned* bar, volatile LAS unsigned* st) {
    XcdBarrier b; b.bar = bar; b.x = xb_xcc_id(); b.st = st;
    if (threadIdx.x == 0) (void)xb_add(&bar[XB_XCNT(b.x)], 1u);
    return b;
}
__device__ __forceinline__ void xcd_barrier_complete(unsigned* bar, unsigned x, unsigned& nloc, unsigned& nx) {
    const unsigned G = gridDim.x * gridDim.y * gridDim.z;
    unsigned sum, cnt, mine, sp = 0u;
    for (;;) {
        sum = 0u; cnt = 0u; mine = 0u;
#pragma unroll
        for (unsigned j = 0; j < 16; ++j) { const unsigned c = xb_ld(&bar[XB_XCNT(j)]); sum += c; cnt += (c > 0u) ? 1u : 0u; mine = (j == x) ? c : mine; }
        if (sum == G) break;
        __builtin_amdgcn_s_sleep(1);
        if ((++sp & 255u) == 0u) { if (xb_ld(&bar[XB_TMO])) break; if (sp > XB_SPIN_CAP) { atomicAdd(&bar[XB_TMO], 1u); break; } }
    }
    nloc = mine > 0u ? mine : 1u; nx = cnt > 0u ? cnt : 1u;
}
__device__ __forceinline__ void xcd_barrier(const XcdBarrier& b) {
    asm volatile("s_waitcnt vmcnt(0)" ::: "memory");
    __syncthreads();
    if (threadIdx.x == 0) {
        unsigned* bar = b.bar;
        __builtin_amdgcn_s_waitcnt(0);
        unsigned nloc = b.st[0], nx = b.st[1];
        if (nloc == 0u) { xcd_barrier_complete(bar, b.x, nloc, nx); b.st[0] = nloc; b.st[1] = nx; }
        const unsigned old = xb_add(&bar[XB_XSUB(b.x)], 1u);
        const unsigned gen = old / nloc;
        if (old + 1u == (gen + 1u) * nloc) {
            __builtin_amdgcn_fence(__ATOMIC_RELEASE, "agent");
            asm volatile("s_waitcnt vmcnt(0)" ::: "memory");
            const unsigned og = xb_add(&bar[XB_TOP], 1u);
            const unsigned tg = og / nx;
            if (og + 1u == (tg + 1u) * nx) xb_add(&bar[XB_TOPGEN], 1u);
            else XB_SPIN(xb_ld(&bar[XB_TOPGEN]) == tg, bar);
            __builtin_amdgcn_fence(__ATOMIC_ACQUIRE, "agent");
            xb_add(&bar[XB_XGEN(b.x)], 1u);
            asm volatile("s_waitcnt vmcnt(0)" ::: "memory");
        } else {
            XB_SPIN(xb_ld(&bar[XB_XGEN(b.x)]) == gen, bar);
            __builtin_amdgcn_fence(__ATOMIC_ACQUIRE, "agent");
            asm volatile("s_waitcnt vmcnt(0)" ::: "memory");
        }
    }
    __syncthreads();
}

__device__ __forceinline__ void xcc_local_barrier(unsigned* cnt, unsigned n, unsigned& gen) {
    asm volatile("s_waitcnt vmcnt(0)" ::: "memory");
    __syncthreads();
    if (threadIdx.x == 0) {
        (void)xb_add(cnt, 1u);
        const unsigned target = (gen + 1u) * n; unsigned sp = 0u;
        while (xb_ld(cnt) < target) { __builtin_amdgcn_s_sleep(1); if (++sp > XB_SPIN_CAP) break; }
        __builtin_amdgcn_fence(__ATOMIC_ACQUIRE, "agent");
        asm volatile("s_waitcnt vmcnt(0)" ::: "memory");
    }
    __syncthreads();
    ++gen;
}
__device__ __forceinline__ void sub_barrier(unsigned* cnt, unsigned n, unsigned& gen) {
    asm volatile("s_waitcnt vmcnt(0)" ::: "memory");
    __syncthreads();
    if (threadIdx.x == 0) {
        __builtin_amdgcn_fence(__ATOMIC_RELEASE, "agent");
        asm volatile("s_waitcnt vmcnt(0)" ::: "memory");
        (void)xb_add(cnt, 1u);
        const unsigned target = (gen + 1u) * n; unsigned sp = 0u;
        while (xb_ld(cnt) < target) { __builtin_amdgcn_s_sleep(1); if (++sp > XB_SPIN_CAP) break; }
        __builtin_amdgcn_fence(__ATOMIC_ACQUIRE, "agent");
        asm volatile("s_waitcnt vmcnt(0)" ::: "memory");
    }
    __syncthreads();
    ++gen;
}

#define FD __device__ __forceinline__
FD float hw_sin_rev(float f) { return __builtin_amdgcn_sinf(f); }
FD float hw_cos_rev(float f) { return __builtin_amdgcn_cosf(f); }
FD unsigned bitrev32(unsigned v) { return __builtin_bitreverse32(v); }
namespace fftc {
typedef float cf __attribute__((ext_vector_type(2)));
constexpr int LOGM = 14, FM = 1 << LOGM;
constexpr int FPHYS = FM + (FM >> 4) + ((FM >> 9) << 4);
FD int phys(int i) { return i + (i >> 4) + ((i >> 9) << 4); }
FD cf cmul(cf a, cf b) { return a.xx * b + a.yy * (cf){-b.y, b.x}; }
FD cf cmulp(cf a, cf w, cf wp) { return a.xx * w + a.yy * wp; }
FD cf cperp(cf w) { return (cf){-w.y, w.x}; }
FD cf cconj(cf a) { return (cf){a.x, -a.y}; }
FD cf c32(int m) {
    constexpr float C[16] = {1.0f, 0.9807852804032304f, 0.9238795325112867f, 0.8314696123025452f, 0.7071067811865476f, 0.5555702330196022f, 0.3826834323650898f, 0.19509032201612825f,
                             0.0f, -0.19509032201612825f, -0.3826834323650898f, -0.5555702330196022f, -0.7071067811865476f, -0.8314696123025452f, -0.9238795325112867f, -0.9807852804032304f};
    constexpr float S[16] = {0.0f, 0.19509032201612825f, 0.3826834323650898f, 0.5555702330196022f, 0.7071067811865476f, 0.8314696123025452f, 0.9238795325112867f, 0.9807852804032304f,
                             1.0f, 0.9807852804032304f, 0.9238795325112867f, 0.8314696123025452f, 0.7071067811865476f, 0.5555702330196022f, 0.3826834323650898f, 0.19509032201612825f};
    return (cf){C[m], -S[m]};
}
FD cf twid(int e) { const float f = (float)(e & (FM - 1)) * (1.0f / (float)FM); return (cf){hw_cos_rev(f), -hw_sin_rev(f)}; }
FD int rev14(int p) { return (int)(bitrev32((unsigned)p) >> (32 - LOGM)); }

template <bool CONJ> FD cf mul_c32(cf d, int m) {
    if (m == 0) return d;
    if (m == 8) return CONJ ? (cf){-d.y, d.x} : (cf){d.y, -d.x};
    const cf c = CONJ ? cconj(c32(m)) : c32(m);
    return cmul(d, c);
}
template <int S0, int G, bool INV, int NT, int PRUNE = 0>
FD void fft_pass(LAS cf* X, int tid) {
    constexpr int R = 1 << G;
    constexpr int LOGHG = LOGM - S0 - G, HG = 1 << LOGHG;
    constexpr int NGRP = FM >> G;
    for (int gid = tid; gid < NGRP; gid += NT) {
        const int lo = gid & (HG - 1), hi = gid >> LOGHG, base = (hi << (LOGHG + G)) + lo;
        cf v[R];
#pragma unroll
        for (int q = 0; q < R; ++q) { if (PRUNE == 1 && q >= R / 2) v[q] = (cf){0.f, 0.f}; else v[q] = X[phys(base + q * HG)]; }
        cf Tp[G];
        if (HG > 1) { Tp[0] = twid(lo << S0); if (INV) Tp[0] = cconj(Tp[0]);
#pragma unroll
            for (int st = 1; st < G; ++st) Tp[st] = cmul(Tp[st - 1], Tp[st - 1]); }
#pragma unroll
        for (int sti = 0; sti < G; ++sti) {
            const int st = INV ? (G - 1 - sti) : sti;
            const int dq = R >> (st + 1);
#pragma unroll
            for (int qq = 0; qq < dq; ++qq) {
                const int m = qq * 16 / dq;
                cf W = (cf){1.f, 0.f}, Wp = (cf){0.f, 1.f};
                if (HG > 1) { W = mul_c32<INV>(Tp[st], m); Wp = cperp(W); }
#pragma unroll
                for (int blk = 0; blk < R / (2 * dq); ++blk) {
                    const int q = blk * 2 * dq + qq;
                    const cf a = v[q], b = v[q + dq];
                    if (!INV) { if (PRUNE == 1 && st == 0) { v[q + dq] = (HG > 1) ? cmulp(a, W, Wp) : mul_c32<false>(a, m); }
                        else { v[q] = a + b; cf d = a - b; v[q + dq] = (HG > 1) ? cmulp(d, W, Wp) : mul_c32<false>(d, m); } }
                    else { const cf bb = (HG > 1) ? cmulp(b, W, Wp) : mul_c32<true>(b, m); v[q] = a + bb; if (!(PRUNE == 2 && st == 0)) v[q + dq] = a - bb; }
                }
            }
        }
#pragma unroll
        for (int q = 0; q < R; ++q) { if (!(PRUNE == 2 && q >= R / 2)) X[phys(base + q * HG)] = v[q]; }
    }
}
FD void pair_pos(int q, int& p, int& p2, int& k) { p = 2 * q; k = rev14(p); p2 = rev14((FM - k) & (FM - 1)); }
FD cf wk2(int k) { const float f = (float)k * (0.5f / (float)FM); return (cf){hw_cos_rev(f), -hw_sin_rev(f)}; }
FD void real_unpack(cf Zk, cf Zk2, cf w, cf& Xk, cf& Xmk) {
    const cf Zc = cconj(Zk2);
    const cf E = 0.5f * (Zk + Zc);
    const cf Dm = 0.5f * (Zk - Zc);
    const cf O = (cf){Dm.y, -Dm.x};
    const cf WO = cmul(w, O);
    Xk = E + WO; Xmk = cconj(E - WO);
}
FD void real_pack(cf Yk, cf Ymk, cf w, cf& Zk, cf& Zk2) {
    const cf Yc = cconj(Ymk);
    const cf Ey = 0.5f * (Yk + Yc);
    const cf Dd = 0.5f * (Yk - Yc);
    const cf Oy = cmul(cconj(w), Dd);
    Zk = (cf){Ey.x - Oy.y, Ey.y + Oy.x};
    Zk2 = (cf){Ey.x + Oy.y, -Ey.y + Oy.x};
}
FD int rev10(int v) { return (int)(bitrev32((unsigned)v) >> 22); }
constexpr int rev4c(int v) { return ((v & 1) << 3) | ((v & 2) << 1) | ((v & 4) >> 1) | ((v & 8) >> 3); }
constexpr int blk0_partner(int e) { return rev4c((16 - rev4c(e)) & 15); }
FD void mid_blocks(int tid, int& a, int& gA, int& gB) { a = ((tid & 31) << 4) | (tid >> 5); gA = (tid == 0) ? 0 : rev10(a); gB = (tid == 0) ? 1 : rev10(1024 - a); }
FD int fp_index(int q) { const int g = q >> 3, j = q & 7; int a, set; if ((g & 1) == 0) { a = rev10(g); set = 0; } else { a = (1024 - rev10(g)) & 511; set = 1; }
    const int tid = ((a & 15) << 5) | (a >> 4); return (tid * 2 + set) * 8 + j; }
template <bool INV> FD void bfly16(cf (&v)[16]) {
#pragma unroll
    for (int sti = 0; sti < 4; ++sti) { const int st = INV ? 3 - sti : sti, dq = 16 >> (st + 1);
#pragma unroll
        for (int qq = 0; qq < dq; ++qq) { const int m = qq * 16 / dq;
#pragma unroll
            for (int blk = 0; blk < 16 / (2 * dq); ++blk) { const int q = blk * 2 * dq + qq; const cf a = v[q], b = v[q + dq];
                if (!INV) { v[q] = a + b; v[q + dq] = mul_c32<false>(a - b, m); } else { const cf bb = mul_c32<true>(b, m); v[q] = a + bb; v[q + dq] = a - bb; } } } }
}
FD void pair_apply(cf& own, cf& par, const f32x4 f, const cf wk) {
    cf Xk, Xmk; real_unpack(own, par, wk, Xk, Xmk);
    const cf Yk = cmul(Xk, (cf){f[0], f[1]}), Ymk = cmul(Xmk, (cf){f[2], f[3]});
    cf Zk, Zk2; real_pack(Yk, Ymk, wk, Zk, Zk2); own = Zk; par = Zk2;
}
FD f32x4 unpack_bf16x4(u32x2 r) { return (f32x4){bflo(r.x), bfhi(r.x), bflo(r.y), bfhi(r.y)}; }
FD void fft_mid(LAS cf* X, int tid, const u32x2* Fp) {
    int a, gA, gB; mid_blocks(tid, a, gA, gB);
    LAS cf* pA = X + phys(16 * gA); LAS cf* pB = X + phys(16 * gB);
    cf vA[16], vB[16];
#pragma unroll
    for (int q = 0; q < 16; ++q) { vA[q] = pA[q]; vB[q] = pB[q]; }
    u32x2 fr[16];
#pragma unroll
    for (int i = 0; i < 16; ++i) fr[i] = Fp[tid * 16 + i];
    bfly16<false>(vA); bfly16<false>(vB);
    const cf twA = wk2((tid == 0) ? 0 : a), twB = wk2((tid == 0) ? 512 : 1024 - a);
    if (tid != 0) {
#pragma unroll
        for (int j = 0; j < 8; ++j) { const cf c = c32(rev4c(2 * j));
            pair_apply(vA[2 * j], vB[15 - 2 * j], unpack_bf16x4(fr[j]), cmul(c, twA));
            pair_apply(vB[2 * j], vA[15 - 2 * j], unpack_bf16x4(fr[8 + j]), cmul(c, twB)); }
    } else {
        { const f32x4 f = unpack_bf16x4(fr[0]); const cf Z0 = vA[0], Zh = vA[1];
          const float Y0 = (Z0.x + Z0.y) * f[0], YM = (Z0.x - Z0.y) * f[2];
          vA[0] = (cf){0.5f * (Y0 + YM), 0.5f * (Y0 - YM)}; const cf Yh = cmul(cconj(Zh), (cf){f[1], f[3]}); vA[1] = cconj(Yh); }
#pragma unroll
        for (int j = 1; j < 8; ++j) pair_apply(vA[2 * j], vA[blk0_partner(2 * j)], unpack_bf16x4(fr[j]), cmul(c32(rev4c(2 * j)), twA));
#pragma unroll
        for (int j = 0; j < 8; ++j) pair_apply(vB[2 * j], vB[15 - 2 * j], unpack_bf16x4(fr[8 + j]), cmul(c32(rev4c(2 * j)), twB));
    }
    bfly16<true>(vA); bfly16<true>(vB);
#pragma unroll
    for (int q = 0; q < 16; ++q) { pA[q] = vA[q]; pB[q] = vB[q]; }
}
FD void fft_mid_filter(LAS cf* X, int tid, bf16_t* row, float sc) {
    int a, gA, gB; mid_blocks(tid, a, gA, gB);
    const LAS cf* pA = X + phys(16 * gA); const LAS cf* pB = X + phys(16 * gB);
    cf vA[16], vB[16];
#pragma unroll
    for (int q = 0; q < 16; ++q) { vA[q] = pA[q]; vB[q] = pB[q]; }
    bfly16<false>(vA); bfly16<false>(vB);
    const cf twA = wk2((tid == 0) ? 0 : a), twB = wk2((tid == 0) ? 512 : 1024 - a);
    u32x2 o[16];
#define FMF_PUT_(idx, own, par, wkv) do { cf Xk_, Xmk_; real_unpack(own, par, wkv, Xk_, Xmk_); o[idx].x = cvt_pk_bf16(Xk_.x * sc, Xk_.y * sc); o[idx].y = cvt_pk_bf16(Xmk_.x * sc, Xmk_.y * sc); } while (0)
    if (tid != 0) {
#pragma unroll
        for (int j = 0; j < 8; ++j) { const cf c = c32(rev4c(2 * j));
            FMF_PUT_(j, vA[2 * j], vB[15 - 2 * j], cmul(c, twA));
            FMF_PUT_(8 + j, vB[2 * j], vA[15 - 2 * j], cmul(c, twB)); }
    } else {
        { const cf Z0 = vA[0], Zh = vA[1]; o[0].x = cvt_pk_bf16((Z0.x + Z0.y) * sc, Zh.x * sc); o[0].y = cvt_pk_bf16((Z0.x - Z0.y) * sc, -Zh.y * sc); }
#pragma unroll
        for (int j = 1; j < 8; ++j) FMF_PUT_(j, vA[2 * j], vA[blk0_partner(2 * j)], cmul(c32(rev4c(2 * j)), twA));
#pragma unroll
        for (int j = 0; j < 8; ++j) FMF_PUT_(8 + j, vB[2 * j], vB[15 - 2 * j], cmul(c32(rev4c(2 * j)), twB));
    }
#undef FMF_PUT_
    u32x4* dst = (u32x4*)(row + 64 * tid);
#pragma unroll
    for (int i = 0; i < 8; ++i) dst[i] = (u32x4){o[2 * i].x, o[2 * i].y, o[2 * i + 1].x, o[2 * i + 1].y};
}
FD void fft_forward(LAS cf* X, int tid) {
    fft_pass<0, 5, false, NTHR>(X, tid); __syncthreads();
    fft_pass<5, 5, false, NTHR>(X, tid); __syncthreads();
    fft_pass<10, 4, false, NTHR>(X, tid); __syncthreads();
}
FD void fft_inverse(LAS cf* X, int tid) {
    fft_pass<10, 4, true, NTHR>(X, tid); __syncthreads();
    fft_pass<5, 5, true, NTHR>(X, tid); __syncthreads();
    fft_pass<0, 5, true, NTHR>(X, tid); __syncthreads();
}
}

struct Args {
    const float* in[33]; float* out; unsigned char* ws;
    double invf[32];
};
enum { I_X = 0, I_C, I_CTX, I_CCTX, I_WADA, I_BADA, I_NPRE, I_NPOST, I_WFIN, I_WFOUT, I_HWIN, I_HBIN, I_HWSC, I_HBSC, I_FW1, I_FB1, I_FW2, I_FB2, I_FW3, I_FB3, I_FW4, I_FFREQ, I_HSKIP, I_HWOUT, I_HBOUT,
       I_AWQKV, I_ABQKV, I_ASINK, I_AWO, I_ABO, I_PW, I_PB, I_PSCALE };

__device__ __forceinline__ const CAS char* kargs() { const CAS char* p = (const CAS char*)__builtin_amdgcn_kernarg_segment_ptr(); asm volatile("" : "+s"(p)); return p; }
#define IN(i) (*(const float* const CAS*)(kargs() + 8 * (i)))
#define OUTP (*(float* const CAS*)(kargs() + 8 * 33))
#define WSP (*(unsigned char* const CAS*)(kargs() + 8 * 34))
#define INVF(j) (*(const CAS double*)(kargs() + 8 * 35 + 8 * (j)))
struct Frame {
    LAS unsigned char* lds;
    int tid, lane, wave, G, bid, vcu;
    unsigned char* ws;
};
__device__ __forceinline__ LAS unsigned char* lds_dyn() { extern __shared__ __attribute__((aligned(16))) unsigned char lds_raw[]; return (LAS unsigned char*)lds_raw; }
__device__ __forceinline__ Frame mk_frame() {
    extern __shared__ __attribute__((aligned(16))) unsigned char lds_raw[];
    Frame F; int tid = threadIdx.x; asm volatile("" : "+v"(tid));
    F.lds = (LAS unsigned char*)lds_raw; F.tid = tid; F.lane = tid & 63; F.wave = __builtin_amdgcn_readfirstlane(tid >> 6);
    F.G = gridDim.x; F.bid = blockIdx.x; F.ws = WSP;
    F.vcu = (int)((volatile LAS unsigned*)(F.lds + MISC_OFF))[18]; return F;
}
__device__ __forceinline__ Frame mk_frame_group(int first, int n) { Frame F = mk_frame(); F.bid = (int)blockIdx.x - first; F.G = n; F.vcu = F.bid; return F; }

__device__ __forceinline__ int srccol(int r, int mode) {
    if (mode == 1) { const int pn = r >> 8, w = r & 255; return (w < 128) ? (128 * pn + w) : (DFF + 128 * pn + (w - 128)); }
    if (mode == 2 && r < 2560) { const int e = r & 127, f = e & 63; return (r & ~127) + (e & 64) + (f & 1) * 32 + (f >> 1); }
    return r;
}
struct CvtDesc { const float* W; bf16_t* WT; int K, N, mode, ldw, item; };
__device__ __forceinline__ void cvt_load(const CvtDesc& d, int lane, float (&wv)[32]) {
    const int nblk = d.N / 32, kb = d.item / nblk, nb = d.item % nblk, k0 = 64 * kb, r0 = 32 * nb;
    const int ncol = srccol(r0 + (lane & 31), d.mode);
#pragma unroll
    for (int i = 0; i < 32; ++i) wv[i] = __builtin_nontemporal_load(d.W + (size_t)(k0 + 2 * i + (lane >> 5)) * d.N + ncol);
}
__device__ __forceinline__ void cvt_store(const CvtDesc& d, int lane, const float (&wv)[32], LAS float* scr) {
    const int nblk = d.N / 32, kb = d.item / nblk, nb = d.item % nblk, k0 = 64 * kb, r0 = 32 * nb;
#pragma unroll
    for (int i = 0; i < 32; ++i) scr[(2 * i + (lane >> 5)) * 33 + (lane & 31)] = wv[i];
    LDS_WAIT(); asm volatile("" ::: "memory");
    const int c = lane & 7;
#pragma unroll
    for (int j = 0; j < 4; ++j) { const int n = (lane >> 3) + 8 * j; const LAS float* s = scr + (8 * c) * 33 + n;
        u32x4 o; o.x = cvt_pk_bf16(s[0 * 33], s[1 * 33]); o.y = cvt_pk_bf16(s[2 * 33], s[3 * 33]); o.z = cvt_pk_bf16(s[4 * 33], s[5 * 33]); o.w = cvt_pk_bf16(s[6 * 33], s[7 * 33]);
        *(u32x4*)(d.WT + (size_t)(r0 + n) * d.ldw + k0 + 8 * c) = o; }
    LDS_WAIT(); asm volatile("" ::: "memory");
}
namespace cvt {
constexpr int I_IN = (D / 64) * (2 * DFF / 32), I_OUT = (DFF / 64) * (D / 32), I_HI = (D / 64) * (3 * D / 32), I_SQ = (D / 64) * (D / 32), I_QK = (D / 64) * (QKVD / 32), I_PL = (512 / 64) * (512 / 32);
constexpr int N0 = 3 * I_IN + 3 * I_OUT + I_HI + I_SQ + I_QK;
constexpr int N1 = 5 * I_IN + 5 * I_OUT + I_HI + I_SQ + I_SQ + 4 * I_PL;
}
__device__ __forceinline__ CvtDesc cvt_win(const Frame& F, int j, int r) { return CvtDesc{IN(I_WFIN) + (size_t)j * D * 2 * DFF, (bf16_t*)(F.ws + WS_WIN) + (size_t)j * 2 * DFF * D, D, 2 * DFF, 1, D, r}; }
__device__ __forceinline__ CvtDesc cvt_wout(const Frame& F, int j, int r) { return CvtDesc{IN(I_WFOUT) + (size_t)j * DFF * D, (bf16_t*)(F.ws + WS_WOUT) + (size_t)j * WOUT_STRIDE, DFF, D, 0, DFFP, r}; }
__device__ __forceinline__ CvtDesc cvt_hin(const Frame& F, int j, int r) { return CvtDesc{IN(I_HWIN) + (size_t)j * D * 3 * D, (bf16_t*)(F.ws + WS_WHIN) + (size_t)j * 3 * D * D, D, 3 * D, 0, D, r}; }
__device__ __forceinline__ CvtDesc cvt_hout(const Frame& F, int j, int r) { return CvtDesc{IN(I_HWOUT) + (size_t)j * D * D, (bf16_t*)(F.ws + WS_WHOUT) + (size_t)j * D * D, D, D, 0, D, r}; }
__device__ __forceinline__ CvtDesc cvt_desc(const Frame& F, int list, int it) {
    using namespace cvt;
    if (list == 0) {
        if (it < 3 * I_IN) return cvt_win(F, it / I_IN, it % I_IN); it -= 3 * I_IN;
        if (it < 3 * I_OUT) return cvt_wout(F, it / I_OUT, it % I_OUT); it -= 3 * I_OUT;
        if (it < I_HI) return cvt_hin(F, 0, it); it -= I_HI;
        if (it < I_SQ) return cvt_hout(F, 0, it); it -= I_SQ;
        return CvtDesc{IN(I_AWQKV), (bf16_t*)(F.ws + WS_WQKV), D, QKVD, 2, D, it};
    }
    if (it < 5 * I_IN) return cvt_win(F, 3 + it / I_IN, it % I_IN); it -= 5 * I_IN;
    if (it < 5 * I_OUT) return cvt_wout(F, 3 + it / I_OUT, it % I_OUT); it -= 5 * I_OUT;
    if (it < I_HI) return cvt_hin(F, 1, it); it -= I_HI;
    if (it < I_SQ) return cvt_hout(F, 1, it); it -= I_SQ;
    if (it < I_SQ) return CvtDesc{IN(I_AWO), (bf16_t*)(F.ws + WS_WO), D, D, 0, D, it}; it -= I_SQ;
    { const int j = it / I_PL; return CvtDesc{IN(I_PW) + (size_t)j * 512 * 512, (bf16_t*)(F.ws + WS_WP) + (size_t)j * 512 * 512, 512, 512, 0, 512, it % I_PL}; }
}
__device__ __forceinline__ void p0_convert(const Frame& F, int wsub, int nw, int list) {
    LAS float* scr = (LAS float*)(F.lds + wsub * 8704);
    const int gw = F.bid * nw + wsub, NGW = F.G * nw;
    const int NIT = list == 0 ? cvt::N0 : cvt::N1;
    int it = gw; if (it >= NIT) return;
    float va[32], vb[32];
    CvtDesc da = cvt_desc(F, list, it), db = da;
    cvt_load(da, F.lane, va);
    for (;;) {
        const int itb = it + NGW; const bool hb = itb < NIT;
        if (hb) { db = cvt_desc(F, list, itb); cvt_load(db, F.lane, vb); }
        cvt_store(da, F.lane, va, scr);
        if (!hb) break;
        const int ita = itb + NGW; const bool ha = ita < NIT;
        if (ha) { da = cvt_desc(F, list, ita); cvt_load(da, F.lane, va); }
        cvt_store(db, F.lane, vb, scr);
        if (!ha) break;
        it = ita;
    }
}

__device__ __forceinline__ void p0_mods(const Frame& F) {
    LAS float* sc = (LAS float*)(F.lds + 69632);
    LAS float* red = sc + 4096;
    { const float* cp = IN(I_C); const float* ccp = IN(I_CCTX);
      for (int i = F.tid; i < D; i += NTHR) { sc[i] = silu_f(cp[i]); sc[D + i] = silu_f(ccp[i]); } }
    __syncthreads();
    float* mod = (float*)(F.ws + WS_MOD); float* modc = (float*)(F.ws + WS_MOD + 512 * 1024);
    const float* bada = IN(I_BADA); const float* wada = IN(I_WADA);
    constexpr int NCOL = DEPTH * NMOD * D, CPB = 288, NG = CPB / 32;
    for (int fc0 = F.bid * CPB; fc0 < NCOL; fc0 += F.G * CPB) {
        const int l = fc0 / (NMOD * D), j0 = fc0 % (NMOD * D), cl = F.lane & 31, rp = F.lane >> 5;
        const float* wp = wada + ((size_t)l * D + (size_t)F.wave * 256 + rp) * (NMOD * D) + j0 + cl;
        float a0[NG], a1[NG];
#pragma unroll
        for (int g = 0; g < NG; ++g) { a0[g] = 0.f; a1[g] = 0.f; }
#pragma unroll 4
        for (int kk = 0; kk < 128; ++kk) {
            const float s0 = sc[F.wave * 256 + 2 * kk + rp], s1 = sc[D + F.wave * 256 + 2 * kk + rp];
#pragma unroll
            for (int g = 0; g < NG; ++g) { const float w = __builtin_nontemporal_load(wp + (size_t)(2 * kk) * (NMOD * D) + 32 * g); a0[g] += w * s0; a1[g] += w * s1; } }
#pragma unroll
        for (int g = 0; g < NG; ++g) { a0[g] += __shfl_xor(a0[g], 32); a1[g] += __shfl_xor(a1[g], 32); }
        if (rp == 0) {
#pragma unroll
            for (int g = 0; g < NG; ++g) { red[(F.wave * 2 + 0) * CPB + 32 * g + cl] = a0[g]; red[(F.wave * 2 + 1) * CPB + 32 * g + cl] = a1[g]; } }
        __syncthreads();
        for (int i = F.tid; i < 2 * CPB; i += NTHR) { const int sidx = i / CPB, col = i % CPB; float v = 0.f;
#pragma unroll
            for (int w = 0; w < 8; ++w) v += red[(w * 2 + sidx) * CPB + col];
            const int j = j0 + col; v += bada[l * (NMOD * D) + j];
            if (sidx == 0) mod[l * (NMOD * D) + j] = v; else if (l < 2) modc[l * (NMOD * D) + j] = v; }
        __syncthreads();
    }
}

__device__ __forceinline__ void p0_rope(const Frame& F) {
    f32x2* tab = (f32x2*)(F.ws + WS_ROPE);
    for (int i = F.bid * NTHR + F.tid; i < 256 * 32; i += F.G * NTHR) {
        const int pos = i >> 5, j = i & 31;
        const double rev = (double)pos * INVF(j) * 0.15915494309189535;
        const float fr = (float)(rev - floor(rev));
        tab[i] = (f32x2){__builtin_amdgcn_cosf(fr), __builtin_amdgcn_sinf(fr)};
    }
    float* bqp = (float*)(F.ws + WS_BQP); const float* bq = IN(I_ABQKV); const float* hbo = IN(I_HBOUT);
    for (int i = F.bid * NTHR + F.tid; i < QKVD + 2 * D; i += F.G * NTHR) bqp[i] = (i < QKVD) ? bq[srccol(i, 2)] : 0.25f * hbo[i - QKVD];
}

__device__ __forceinline__ float sin_rad(float x) { const float r = x * 0.15915494309189535f; return __builtin_amdgcn_sinf(r - floorf(r)); }
__device__ __forceinline__ void p0_hidden(const Frame& F, int wsub, int nw, int set_lo, int set_hi) {
    LAS float* hb = (LAS float*)(F.lds + 102400 + F.wave * 2048);
    const int lane = F.lane;
    for (int set = set_lo; set < set_hi; ++set)
    for (int tb = F.bid; tb < ((set == 2) ? CTX : SEQ) / (4 * nw); tb += F.G) {
        const int hj = (set == 1) ? 1 : 0, L = (set == 2) ? CTX : SEQ, t0 = (tb * nw + wsub) * 4;
        const float* w1 = IN(I_FW1) + hj * 33 * 64; const float* b1 = IN(I_FB1) + hj * 64;
        const float* w2 = IN(I_FW2) + hj * 64 * 64; const float* b2 = IN(I_FB2) + hj * 64;
        const float* w3 = IN(I_FW3) + hj * 64 * 64; const float* b3 = IN(I_FB3) + hj * 64;
        const float* fq = IN(I_FFREQ) + hj * 3 * 64;
        if (lane < 33) {
#pragma unroll
            for (int e = 0; e < 4; ++e) { const int t = t0 + e; float z;
                if (lane == 0) z = (float)t / (float)(L - 1);
                else { const int bi = (lane - 1) & 15; const double band = 1e-4 + (double)bi * ((15.0 - 1e-4) / 15.0); const double rev = band * (double)t / (double)L; const float fr = (float)(rev - floor(rev));
                    z = (lane <= 16) ? __builtin_amdgcn_cosf(fr) : -__builtin_amdgcn_sinf(fr); }
                hb[e * 128 + lane] = z; }
        }
        LDS_WAIT(); __builtin_amdgcn_wave_barrier();
        float acc[4], f[4];
#pragma unroll
        for (int e = 0; e < 4; ++e) acc[e] = b1[lane];
#pragma unroll 11
        for (int i = 0; i < 33; ++i) { const float w = w1[i * 64 + lane];
#pragma unroll
            for (int e = 0; e < 4; ++e) acc[e] += hb[e * 128 + i] * w; }
#pragma unroll
        for (int e = 0; e < 4; ++e) f[e] = sin_rad(fq[lane] * acc[e]);
        LDS_WAIT(); __builtin_amdgcn_wave_barrier();
#pragma unroll
        for (int e = 0; e < 4; ++e) hb[e * 128 + 64 + lane] = f[e];
        LDS_WAIT(); __builtin_amdgcn_wave_barrier();
#pragma unroll
        for (int e = 0; e < 4; ++e) acc[e] = b2[lane];
#pragma unroll 16
        for (int i = 0; i < 64; ++i) { const float w = w2[i * 64 + lane];
#pragma unroll
            for (int e = 0; e < 4; ++e) acc[e] += hb[e * 128 + 64 + i] * w; }
#pragma unroll
        for (int e = 0; e < 4; ++e) f[e] = sin_rad(fq[64 + lane] * acc[e]);
        LDS_WAIT(); __builtin_amdgcn_wave_barrier();
#pragma unroll
        for (int e = 0; e < 4; ++e) hb[e * 128 + lane] = f[e];
        LDS_WAIT(); __builtin_amdgcn_wave_barrier();
#pragma unroll
        for (int e = 0; e < 4; ++e) acc[e] = b3[lane];
#pragma unroll 16
        for (int i = 0; i < 64; ++i) { const float w = w3[i * 64 + lane];
#pragma unroll
            for (int e = 0; e < 4; ++e) acc[e] += hb[e * 128 + i] * w; }
#pragma unroll
        for (int e = 0; e < 4; ++e) ((float*)(F.ws + WS_HID))[((size_t)set * SEQ + t0 + e) * 64 + lane] = sin_rad(fq[128 + lane] * acc[e]);
        LDS_WAIT(); __builtin_amdgcn_wave_barrier();
    }
}

typedef float f32x16 __attribute__((ext_vector_type(16)));
__device__ __forceinline__ void split_hilo(const float (&v)[8], bf16x8& hi, bf16x8& lo) {
    u32x4 h, l;
#pragma unroll
    for (int e = 0; e < 4; ++e) { const unsigned hw = cvt_pk_bf16(v[2 * e], v[2 * e + 1]); h[e] = hw; l[e] = cvt_pk_bf16(v[2 * e] - bflo(hw), v[2 * e + 1] - bfhi(hw)); }
    hi = __builtin_bit_cast(bf16x8, h); lo = __builtin_bit_cast(bf16x8, l);
}
typedef float f32x16v __attribute__((ext_vector_type(16)));
template <bool CTXSET> __device__ __forceinline__ void p0_filter_td(const Frame& F, int wsub, int nw, int it_lo, int it_hi) {
    const int hf = F.lane >> 5, li = F.lane & 31;
    const float* w4base = IN(I_FW4);
    for (int it = it_lo + F.bid; it < it_hi; it += F.G) {
        const int dir = it & 1, i2 = it >> 1;
        int set, cg, tq, ntile; if (i2 < 512) { set = i2 >> 8; cg = (i2 & 255) >> 2; tq = i2 & 3; ntile = 128; } else { set = 2; cg = i2 - 512; tq = 0; ntile = 8; }
        const int hj = (set == 1) ? 1 : 0, L = (set == 2) ? CTX : SEQ, L2 = 2 * L, c0 = cg * 32;
        const float* w4 = w4base + (size_t)hj * 64 * 2 * D + dir * D;
        bf16x8 Ah[4], Al[4];
#pragma unroll
        for (int ks = 0; ks < 4; ++ks) { float v[8];
#pragma unroll
            for (int jj = 0; jj < 8; ++jj) v[jj] = w4[(16 * ks + 8 * hf + jj) * (2 * D) + c0 + li];
            split_hilo(v, Ah[ks], Al[ks]); }
        float* outc = (float*)(F.ws + WS_FILTC); bf16_t* outb = (bf16_t*)(F.ws + WS_FILT + (size_t)(set & 1) * 128 * MiB);
        const float* hid = (const float*)(F.ws + WS_HID) + (size_t)set * SEQ * 64;
        f32x4 Bv[8], Bn[8];
        int tile = tq * 128 + wsub; const int tend = tq * 128 + ntile;
        if (tile < tend) { const int t = tile * 32 + li;
#pragma unroll
            for (int ks = 0; ks < 4; ++ks) { Bv[2 * ks] = *(const f32x4*)(hid + (size_t)t * 64 + 16 * ks + 8 * hf); Bv[2 * ks + 1] = *(const f32x4*)(hid + (size_t)t * 64 + 16 * ks + 8 * hf + 4); } }
        for (; tile < tend; tile += nw) {
            const int t = tile * 32 + li;
            const bool hn = tile + nw < tend;
            if (hn) { const int tn2 = (tile + nw) * 32 + li;
#pragma unroll
                for (int ks = 0; ks < 4; ++ks) { Bn[2 * ks] = *(const f32x4*)(hid + (size_t)tn2 * 64 + 16 * ks + 8 * hf); Bn[2 * ks + 1] = *(const f32x4*)(hid + (size_t)tn2 * 64 + 16 * ks + 8 * hf + 4); } }
            f32x16v acc;
#pragma unroll
            for (int r = 0; r < 16; ++r) acc[r] = 0.f;
#pragma unroll
            for (int ks = 0; ks < 4; ++ks) {
                const float v[8] = {Bv[2 * ks][0], Bv[2 * ks][1], Bv[2 * ks][2], Bv[2 * ks][3], Bv[2 * ks + 1][0], Bv[2 * ks + 1][1], Bv[2 * ks + 1][2], Bv[2 * ks + 1][3]};
                bf16x8 bh, bl; split_hilo(v, bh, bl);
                acc = __builtin_amdgcn_mfma_f32_32x32x16_bf16(Al[ks], bh, acc, 0, 0, 0);
                acc = __builtin_amdgcn_mfma_f32_32x32x16_bf16(Ah[ks], bl, acc, 0, 0, 0);
                acc = __builtin_amdgcn_mfma_f32_32x32x16_bf16(Ah[ks], bh, acc, 0, 0, 0);
            }
            const float tn = (float)t / (float)(L - 1);
#pragma unroll
            for (int r = 0; r < 16; ++r) { const int c = c0 + (r & 3) + 8 * (r >> 2) + 4 * hf;
                const float lin = -3.0701134573253943f + (float)c * ((-15.350567286626972f + 3.0701134573253943f) / (float)(D - 1));
                const float dec = __builtin_amdgcn_exp2f(-1.4426950408889634f * tn * fabsf(lin));
                const float val = acc[r] * dec;
                if (CTXSET) { float* orow = outc + (size_t)c * L2;
                    if (dir == 0) orow[t] = val; else { if (t == 0) orow[L] = 0.f; else orow[L2 - t] = val; } }
                else { bf16_t* orow = outb + (size_t)c * L2;
                    if (dir == 0) orow[t] = f2bf(val); else { if (t == 0) orow[L] = (bf16_t)0; else orow[L2 - t] = f2bf(val); } } }
            if (hn) {
#pragma unroll
                for (int j = 0; j < 8; ++j) Bv[j] = Bn[j]; }
        }
    }
}

__device__ __forceinline__ void p0_filter_fft(const Frame& F) {
    using namespace fftc;
    LAS cf* X = (LAS cf*)F.lds;
    for (int it = F.bid; it < 2 * D; it += F.G) {
        int tid = F.tid; asm volatile("" : "+v"(tid));
        bf16_t* row = (bf16_t*)(F.ws + WS_FILT + (size_t)(it / D) * 128 * MiB) + (size_t)(it % D) * (2 * SEQ);
#pragma unroll
        for (int i = tid; i < FM / 4; i += NTHR) { const u32x4 v = *(const u32x4*)(row + 8 * i); LAS cf* d = X + phys(4 * i);
            d[0] = (cf){bflo(v[0]), bfhi(v[0])}; d[1] = (cf){bflo(v[1]), bfhi(v[1])}; d[2] = (cf){bflo(v[2]), bfhi(v[2])}; d[3] = (cf){bflo(v[3]), bfhi(v[3])}; }
        __syncthreads();
        unsigned pfn = 0u;
        if (it + F.G < 2 * D) { const int nx = it + F.G; pfn = *(const unsigned*)((const bf16_t*)(F.ws + WS_FILT + (size_t)(nx / D) * 128 * MiB) + (size_t)(nx % D) * (2 * SEQ) + 64 * tid); }
        fft_pass<0, 5, false, NTHR>(X, tid); __syncthreads();
        fft_pass<5, 5, false, NTHR>(X, tid); __syncthreads();
        asm volatile("" :: "v"(pfn));
        fft_mid_filter(X, tid, row, 1.0f / (float)FM);
        __syncthreads();
    }
}

__device__ __forceinline__ void thin_phase(const Frame& F, int ph, bool ctx) {
    LAS float* cA = (LAS float*)F.lds;
    LAS float* cB = cA + D; LAS float* cC = cA + 2 * D;
    const float* mod = ctx ? (const float*)(F.ws + WS_MOD + 512 * 1024) : (const float*)(F.ws + WS_MOD);
    const int l = ph / 3, k = ph % 3, pl = (ph - 1) / 3, pk = (ph - 1) % 3;
    const bool has_prev = ph >= 1, has_next = ph < 12;
    const float* npost = IN(I_NPOST); const float* npre = IN(I_NPRE); const float* xin = ctx ? IN(I_CTX) : IN(I_X); float* outp = OUTP;
    for (int i = F.tid; i < D; i += NTHR) {
        if (has_prev) { const float wgt = (pk == 1) ? 1.0f : 0.5f, gp = npost[(pl * 3 + pk) * D + i]; cA[i] = wgt * gp * mod[pl * (NMOD * D) + (3 * pk + 2) * D + i]; }
        if (has_next) { const float g = npre[(l * 3 + k) * D + i]; cB[i] = g * (1.0f + mod[l * (NMOD * D) + (3 * k + 1) * D + i]); cC[i] = mod[l * (NMOD * D) + (3 * k) * D + i]; }
    }
    __syncthreads();
    const int row0 = ctx ? SEQ : 0, nrows = ctx ? CTX : SEQ;
    _Float16* H = (_Float16*)(F.ws + WS_H); const bf16_t* Y = (const bf16_t*)(F.ws + WS_Y); bf16_t* U = (bf16_t*)(F.ws + WS_U); const bf16_t* PP = (const bf16_t*)(F.ws + WS_P);
    const int nsplit = (pk != 1) ? 11 : 4;
    const bool xl = !ctx && ((volatile LAS unsigned*)(F.lds + MISC_OFF))[19] != 0u && F.G == 256;
    const int rstart = xl ? (F.vcu & 7) * 2048 + (F.vcu >> 3) * NWAVES + F.wave : F.bid * NWAVES + F.wave;
    const int rstep = xl ? 256 : F.G * NWAVES, rend = xl ? (F.vcu & 7) * 2048 + 2048 : nrows;
    f16x4 hN[8]; u32x2 yN[8];
    if (ph != 0 && rstart < rend) {
#pragma unroll
        for (int j = 0; j < 8; ++j) { hN[j] = __builtin_nontemporal_load((const f16x4*)(H + (size_t)(row0 + rstart) * D + 4 * (F.lane + 64 * j))); yN[j] = !ctx ? __builtin_nontemporal_load((const u32x2*)(Y + (size_t)(row0 + rstart) * D + 4 * (F.lane + 64 * j))) : (u32x2){0u, 0u}; } }
    for (int r = rstart; r < rend; r += rstep) {
        const int row = row0 + r;
        f32x4 h[8]; u32x2 yc[8];
        if (ph == 0) {
#pragma unroll
            for (int j = 0; j < 8; ++j) { h[j] = __builtin_nontemporal_load((const f32x4*)(xin + (size_t)r * D + 4 * (F.lane + 64 * j))); yc[j] = (u32x2){0u, 0u}; }
        } else {
#pragma unroll
            for (int j = 0; j < 8; ++j) { h[j] = __builtin_convertvector(hN[j], f32x4); yc[j] = yN[j]; }
            if (r + rstep < rend) { const int rn = row0 + r + rstep;
#pragma unroll
                for (int j = 0; j < 8; ++j) { hN[j] = __builtin_nontemporal_load((const f16x4*)(H + (size_t)rn * D + 4 * (F.lane + 64 * j))); yN[j] = !ctx ? __builtin_nontemporal_load((const u32x2*)(Y + (size_t)rn * D + 4 * (F.lane + 64 * j))) : (u32x2){0u, 0u}; } }
        }
        if (has_prev) {
            f32x4 y[8]; float ss = 0.f;
#pragma unroll
            for (int j = 0; j < 8; ++j) {
                if (!ctx) { const u32x2 yr = yc[j]; y[j] = (f32x4){bflo(yr.x), bfhi(yr.x), bflo(yr.y), bfhi(yr.y)}; }
                else { u32x2 yr[11];
#pragma unroll
                    for (int sp = 0; sp < 11; ++sp) yr[sp] = (sp < nsplit) ? *(const u32x2*)(PP + ((size_t)sp * 256 + r) * D + 4 * (F.lane + 64 * j)) : (u32x2){0u, 0u};
                    y[j] = (f32x4){0.f, 0.f, 0.f, 0.f};
#pragma unroll
                    for (int sp = 0; sp < 11; ++sp) y[j] += (f32x4){bflo(yr[sp].x), bfhi(yr[sp].x), bflo(yr[sp].y), bfhi(yr[sp].y)}; }
                if (ctx) asm volatile("" ::: "memory");
                ss += (y[j][0] * y[j][0] + y[j][1] * y[j][1]) + (y[j][2] * y[j][2] + y[j][3] * y[j][3]); }
            const float rstd = 1.0f / sqrtf(wave_sum(ss) * (1.0f / D) + NORM_EPS);
#pragma unroll
            for (int j = 0; j < 8; ++j) { const f32x4 cv = *(const LAS f32x4*)(cA + 4 * (F.lane + 64 * j)); h[j] += cv * (y[j] * rstd); }
        }
        if (!has_next) {
#pragma unroll
            for (int j = 0; j < 8; ++j) __builtin_nontemporal_store(h[j], (f32x4*)(outp + (size_t)row * D + 4 * (F.lane + 64 * j)));
            continue;
        }
        float ss2 = 0.f;
#pragma unroll
        for (int j = 0; j < 8; ++j) { __builtin_nontemporal_store(__builtin_convertvector(h[j], f16x4), (f16x4*)(H + (size_t)row * D + 4 * (F.lane + 64 * j))); ss2 += (h[j][0] * h[j][0] + h[j][1] * h[j][1]) + (h[j][2] * h[j][2] + h[j][3] * h[j][3]); }
        const float rstd2 = 1.0f / sqrtf(wave_sum(ss2) * (1.0f / D) + NORM_EPS);
#pragma unroll
        for (int j = 0; j < 8; ++j) { const f32x4 bv = *(const LAS f32x4*)(cB + 4 * (F.lane + 64 * j)), cv = *(const LAS f32x4*)(cC + 4 * (F.lane + 64 * j));
            const f32x4 u = (h[j] * rstd2) * bv + cv; u32x2 w; w.x = cvt_pk_bf16(u[0], u[1]); w.y = cvt_pk_bf16(u[2], u[3]);
            *(u32x2*)(U + (size_t)row * D + 4 * (F.lane + 64 * j)) = w; }
    }
    __syncthreads();
}

__device__ __forceinline__ void sc8(const bf16_t* row, int t0, int len, float w0, float w1, float w2, float b, float (&o)[8]) {
    const u32x4 raw = *(const u32x4*)(row + t0);
    float x[10];
    x[0] = (t0 > 0) ? bf2f(row[t0 - 1]) : 0.f; x[9] = (t0 + 8 < len) ? bf2f(row[t0 + 8]) : 0.f;
#pragma unroll
    for (int e = 0; e < 4; ++e) { x[1 + 2 * e] = bflo(raw[e]); x[2 + 2 * e] = bfhi(raw[e]); }
#pragma unroll
    for (int e = 0; e < 8; ++e) o[e] = x[e] * w0 + x[e + 1] * w1 + x[e + 2] * w2 + b;
}
__device__ __forceinline__ void sc_pair(const bf16_t* row, int t0, int len, float w0, float w1, float w2, float b, float& o0, float& o1) {
    const unsigned pr = *(const unsigned*)(row + t0); const float x0 = bflo(pr), x1 = bfhi(pr);
    const float xm = (t0 > 0) ? bf2f(row[t0 - 1]) : 0.f, xp = (t0 + 2 < len) ? bf2f(row[t0 + 2]) : 0.f;
    o0 = xm * w0 + x0 * w1 + x1 * w2 + b; o1 = x0 * w0 + x1 * w1 + xp * w2 + b;
}
#if defined(DIAG_MASK)
__device__ __forceinline__ void diag_stamp(int cls) {
#ifndef DIAG_BLK
#define DIAG_BLK 0
#endif
    if (blockIdx.x == DIAG_BLK && threadIdx.x == 0) {
        extern __shared__ __attribute__((aligned(16))) unsigned char lds_raw[];
        volatile LAS unsigned long long* ta = (volatile LAS unsigned long long*)((LAS unsigned char*)lds_raw + MISC_OFF + 256);
        const unsigned long long t = __builtin_amdgcn_s_memrealtime();
        if (ta[0] != 0ull) ta[1 + cls] += t - ta[0];
        ta[0] = t;
    }
}
#define STAMP(cls) diag_stamp(cls)
#else
#define STAMP(cls) do { } while (0)
#endif
#if defined(DIAG_MASK) && defined(DIAG_CONV)
#define CSTAMP(cls) diag_stamp(cls)
#else
#define CSTAMP(cls) do { } while (0)
#endif
struct Taps { float a0, a1, a2, ab, b0, b1, b2, bb, v0, v1, v2, vb, skip; };
__device__ __forceinline__ Taps load_taps(const float* wsc, const float* bsc, const float* skp, int hj, int c) {
    Taps t;
    t.a0 = wsc[c]; t.a1 = wsc[3 * D + c]; t.a2 = wsc[6 * D + c]; t.ab = bsc[c];
    t.b0 = wsc[D + c]; t.b1 = wsc[3 * D + D + c]; t.b2 = wsc[6 * D + D + c]; t.bb = bsc[D + c];
    t.v0 = wsc[2 * D + c]; t.v1 = wsc[3 * D + 2 * D + c]; t.v2 = wsc[6 * D + 2 * D + c]; t.vb = bsc[2 * D + c];
    t.skip = skp[hj * D + c];
    return t;
}
__device__ __forceinline__ void hyena_conv_phase(const Frame& F, int hj, int set) {
    using namespace fftc;
    LAS cf* X = (LAS cf*)F.lds;
    for (int c = F.bid; c < D; c += F.G) {
        int tid = F.tid; asm volatile("" : "+v"(tid));
        CSTAMP(21);
        {
            const bf16_t* ZT = (const bf16_t*)(F.ws + WS_ZT);
            const bf16_t* r1 = ZT + (size_t)(D + c) * MT; const bf16_t* r2 = ZT + (size_t)(2 * D + c) * MT;
            const Taps T = load_taps(IN(I_HWSC) + (size_t)hj * 3 * (3 * D), IN(I_HBSC) + (size_t)hj * (3 * D), IN(I_HSKIP), hj, c);
#pragma unroll
            for (int i = 0; i < 4; ++i) {
                const int ch = i * NTHR + tid, t0 = 8 * ch, n0 = 4 * ch;
                float p[8], q[8]; sc8(r1, t0, SEQ, T.b0, T.b1, T.b2, T.bb, p); sc8(r2, t0, SEQ, T.v0, T.v1, T.v2, T.vb, q);
                LAS cf* dst = X + phys(n0);
                dst[0] = (cf){p[0] * q[0], p[1] * q[1]}; dst[1] = (cf){p[2] * q[2], p[3] * q[3]}; dst[2] = (cf){p[4] * q[4], p[5] * q[5]}; dst[3] = (cf){p[6] * q[6], p[7] * q[7]};
            }
        }
        __syncthreads(); CSTAMP(16);
        const bf16_t* fprow = (const bf16_t*)(F.ws + WS_FILT + (size_t)set * 128 * MiB) + (size_t)c * (2 * SEQ);
        const unsigned pf0 = *(const unsigned*)(fprow + 64 * tid), pf1 = 0u;
        unsigned pz0 = 0u, pz1 = 0u;
        if (c + F.G < D) { const bf16_t* zn = (const bf16_t*)(F.ws + WS_ZT) + (size_t)(c + F.G) * MT;
            pz0 = *(const unsigned*)(zn + (size_t)((tid >> 8) * D) * MT + 64 * (tid & 255));
            if (tid < 256) pz1 = *(const unsigned*)(zn + (size_t)(2 * D) * MT + 64 * tid); }
        fft_pass<0, 5, false, NTHR, 1>(X, tid); __syncthreads();
        fft_pass<5, 5, false, NTHR>(X, tid); __syncthreads(); CSTAMP(17);
        asm volatile("" :: "v"(pf0), "v"(pf1), "v"(pz0), "v"(pz1));
        fft_mid(X, tid, (const u32x2*)((const bf16_t*)(F.ws + WS_FILT + (size_t)set * 128 * MiB) + (size_t)c * (2 * SEQ)));
        __syncthreads(); CSTAMP(18);
        fft_pass<5, 5, true, NTHR>(X, tid); __syncthreads();
        fft_pass<0, 5, true, NTHR, 2>(X, tid); __syncthreads(); CSTAMP(19);
        {
            const bf16_t* ZT = (const bf16_t*)(F.ws + WS_ZT); bf16_t* GT = (bf16_t*)(F.ws + WS_GT);
            const bf16_t* r0 = ZT + (size_t)c * MT; const bf16_t* r1 = ZT + (size_t)(D + c) * MT; const bf16_t* r2 = ZT + (size_t)(2 * D + c) * MT;
            const Taps T = load_taps(IN(I_HWSC) + (size_t)hj * 3 * (3 * D), IN(I_HBSC) + (size_t)hj * (3 * D), IN(I_HSKIP), hj, c);
#pragma unroll 2
            for (int i = 0; i < 4; ++i) {
                const int ch = i * NTHR + tid, t0 = 8 * ch, n0 = 4 * ch;
                const LAS cf* src = X + phys(n0);
                const cf s0 = src[0], s1 = src[1], s2 = src[2], s3 = src[3];
                const f32x4 y0 = (f32x4){s0.x, s0.y, s1.x, s1.y}, y1 = (f32x4){s2.x, s2.y, s3.x, s3.y};
                float x0c[8], p[8], q[8]; sc8(r0, t0, SEQ, T.a0, T.a1, T.a2, T.ab, x0c); sc8(r1, t0, SEQ, T.b0, T.b1, T.b2, T.bb, p); sc8(r2, t0, SEQ, T.v0, T.v1, T.v2, T.vb, q);
                u32x4 o;
                o.x = cvt_pk_bf16(x0c[0] * (y0[0] + p[0] * q[0] * T.skip), x0c[1] * (y0[1] + p[1] * q[1] * T.skip));
                o.y = cvt_pk_bf16(x0c[2] * (y0[2] + p[2] * q[2] * T.skip), x0c[3] * (y0[3] + p[3] * q[3] * T.skip));
                o.z = cvt_pk_bf16(x0c[4] * (y1[0] + p[4] * q[4] * T.skip), x0c[5] * (y1[1] + p[5] * q[5] * T.skip));
                o.w = cvt_pk_bf16(x0c[6] * (y1[2] + p[6] * q[6] * T.skip), x0c[7] * (y1[3] + p[7] * q[7] * T.skip));
                *(u32x4*)(GT + (size_t)c * MT + t0) = o;
            }
        }
        __syncthreads(); CSTAMP(20);
    }
}
__device__ __forceinline__ void hyena_conv_ctx(const Frame& F, int hj) {
    const bf16_t* ZT = (const bf16_t*)(F.ws + WS_ZT); bf16_t* GT = (bf16_t*)(F.ws + WS_GT);
    const int qd = F.tid >> 7, t = F.tid & 127;
    LAS float* wb = (LAS float*)F.lds + qd * (3 * CTX); LAS float* fb = wb + CTX;
    for (int c4 = F.bid; c4 < D / 4; c4 += F.G) {
        const int c = 4 * c4 + qd;
        const bf16_t* r0 = ZT + (size_t)c * MT + SEQ; const bf16_t* r1 = ZT + (size_t)(D + c) * MT + SEQ; const bf16_t* r2 = ZT + (size_t)(2 * D + c) * MT + SEQ;
        const Taps T = load_taps(IN(I_HWSC) + (size_t)hj * 3 * (3 * D), IN(I_HBSC) + (size_t)hj * (3 * D), IN(I_HSKIP), hj, c);
        const float* fc = (const float*)(F.ws + WS_FILTC) + (size_t)c * (2 * CTX);
        float wv[2], x0c[2];
#pragma unroll
        for (int o = 0; o < 2; ++o) { const int to = t + 128 * o, te = to & ~1; float p0, p1, q0, q1, xa, xb;
            sc_pair(r1, te, CTX, T.b0, T.b1, T.b2, T.bb, p0, p1); sc_pair(r2, te, CTX, T.v0, T.v1, T.v2, T.vb, q0, q1); sc_pair(r0, te, CTX, T.a0, T.a1, T.a2, T.ab, xa, xb);
            wv[o] = (to & 1) ? p1 * q1 : p0 * q0; x0c[o] = (to & 1) ? xb : xa; wb[to] = wv[o]; }
#pragma unroll
        for (int o = 0; o < 4; ++o) fb[t + 128 * o] = fc[t + 128 * o];
        __syncthreads();
        float a0[8], a1[8];
#pragma unroll
        for (int e = 0; e < 8; ++e) { a0[e] = 0.f; a1[e] = 0.f; }
        for (int s2 = 0; s2 < CTX; s2 += 8) {
#pragma unroll
            for (int e = 0; e < 8; ++e) { const float w = wb[s2 + e]; a0[e] += fb[(t - s2 - e) & (2 * CTX - 1)] * w; a1[e] += fb[(t + 128 - s2 - e) & (2 * CTX - 1)] * w; } }
        const float acc0 = ((a0[0] + a0[1]) + (a0[2] + a0[3])) + ((a0[4] + a0[5]) + (a0[6] + a0[7]));
        const float acc1 = ((a1[0] + a1[1]) + (a1[2] + a1[3])) + ((a1[4] + a1[5]) + (a1[6] + a1[7]));
        GT[(size_t)c * MT + SEQ + t] = f2bf(x0c[0] * (acc0 + wv[0] * T.skip));
        GT[(size_t)c * MT + SEQ + t + 128] = f2bf(x0c[1] * (acc1 + wv[1] * T.skip));
        __syncthreads();
    }
}

__device__ __forceinline__ void transpose_phase(const Frame& F, int trow0, int nrows) {
    LAS bf16_t* tile = (LAS bf16_t*)(F.lds + F.wave * 8704);
    const bf16_t* GT = (const bf16_t*)(F.ws + WS_GT); bf16_t* U = (bf16_t*)(F.ws + WS_U);
    const int ntt = nrows / 64, ntiles = (D / 64) * ntt;
    const int rl = F.lane >> 4, cc = (F.lane & 15) * 4, stride = F.G * NWAVES;
    int it = F.bid * NWAVES + F.wave;
    u32x2 v[16];
    if (it < ntiles) { const int c0 = (it / ntt) * 64, t0 = trow0 + (it % ntt) * 64;
#pragma unroll
        for (int i = 0; i < 16; ++i) v[i] = __builtin_nontemporal_load((const u32x2*)(GT + (size_t)(c0 + 4 * i + rl) * MT + t0 + cc)); }
    for (; it < ntiles; it += stride) {
        const int c0 = (it / ntt) * 64, t0 = trow0 + (it % ntt) * 64;
#pragma unroll
        for (int i = 0; i < 16; ++i) { const int r = 4 * i + rl;
            tile[r * 66 + cc] = (bf16_t)(v[i].x & 0xffff); tile[r * 66 + cc + 1] = (bf16_t)(v[i].x >> 16); tile[r * 66 + cc + 2] = (bf16_t)(v[i].y & 0xffff); tile[r * 66 + cc + 3] = (bf16_t)(v[i].y >> 16); }
        LDS_WAIT(); __builtin_amdgcn_wave_barrier();
        const int nx = it + stride;
        if (nx < ntiles) { const int c1 = (nx / ntt) * 64, t1 = trow0 + (nx % ntt) * 64;
#pragma unroll
            for (int i = 0; i < 16; ++i) v[i] = __builtin_nontemporal_load((const u32x2*)(GT + (size_t)(c1 + 4 * i + rl) * MT + t1 + cc)); }
#pragma unroll 4
        for (int i = 0; i < 16; ++i) { const int t = 4 * i + rl;
            const unsigned e0 = tile[(cc + 0) * 66 + t], e1 = tile[(cc + 1) * 66 + t], e2 = tile[(cc + 2) * 66 + t], e3 = tile[(cc + 3) * 66 + t];
            u32x2 w; w.x = e0 | (e1 << 16); w.y = e2 | (e3 << 16);
            *(u32x2*)(U + (size_t)(t0 + t) * D + c0 + cc) = w; }
        LDS_WAIT(); __builtin_amdgcn_wave_barrier();
    }
}

typedef short s16x4 __attribute__((ext_vector_type(4)));
__device__ __forceinline__ void attn_phase(const Frame& F) {
    constexpr int KP = 288;
    LAS unsigned char* Ks = F.lds; LAS unsigned char* Vs = F.lds + 64 * KP;
    const bf16_t* QKV = (const bf16_t*)(F.ws + WS_ZT); bf16_t* O = (bf16_t*)(F.ws + WS_U); const bf16_t* KVC = (const bf16_t*)(F.ws + WS_KVC);
    const int fr = F.lane & 15, fq = F.lane >> 4; const float* sinkp = IN(I_ASINK);
    for (int unit = F.bid; unit < (SEQ / 128) * 16; unit += F.G) {
        const int qb = unit >> 4, h = unit & 15, kvh = h >> 2, q0 = qb * 128 + 16 * F.wave;
        bf16x8 Qf[4];
#pragma unroll
        for (int ks = 0; ks < 4; ++ks) Qf[ks] = *(const bf16x8*)(QKV + (size_t)(q0 + fr) * QKVD + h * 128 + 32 * ks + 8 * fq);
        float m = sinkp[h] * 1.4426950408889634f;
        float lpart = (fq == 0) ? 1.0f : 0.0f;
        f32x4 Oacc[8];
#pragma unroll
        for (int dt = 0; dt < 8; ++dt) Oacc[dt] = (f32x4){0.f, 0.f, 0.f, 0.f};
        const int ti_first = (qb == 0) ? 2 : 0, nloc = ((qb == SEQ / 128 - 1) ? 4 : 6) - ti_first, nslot = nloc + 4;
        const int lr = F.tid >> 4, lch = F.tid & 15;
        u32x4 pk[2], pv[2];
        { const int krow0 = (qb - 1) * 128 + 64 * ti_first;
#pragma unroll
          for (int hh = 0; hh < 2; ++hh) { const bf16_t* src = QKV + (size_t)(krow0 + lr + 32 * hh) * QKVD + kvh * 128 + lch * 8; pk[hh] = *(const u32x4*)(src + 2048); pv[hh] = *(const u32x4*)(src + 2560); } }
        for (int sl = 0; sl < nslot; ++sl) {
            const bool is_ctx = sl >= nloc;
            const int krow0 = is_ctx ? SEQ + 64 * (sl - nloc) : (qb - 1) * 128 + 64 * (ti_first + sl);
            __syncthreads();
#pragma unroll
            for (int hh = 0; hh < 2; ++hh) { *(LAS u32x4*)(Ks + (lr + 32 * hh) * KP + lch * 16) = pk[hh]; *(LAS u32x4*)(Vs + (lr + 32 * hh) * KP + lch * 16) = pv[hh]; }
            __syncthreads();
            if (sl + 1 < nslot) { const int s2 = sl + 1;
                if (s2 >= nloc) {
#pragma unroll
                    for (int hh = 0; hh < 2; ++hh) { const bf16_t* src = KVC + (size_t)(64 * (s2 - nloc) + lr + 32 * hh) * 1024 + kvh * 128 + lch * 8; pk[hh] = *(const u32x4*)src; pv[hh] = *(const u32x4*)(src + 512); }
                } else { const int kn = (qb - 1) * 128 + 64 * (ti_first + s2);
#pragma unroll
                    for (int hh = 0; hh < 2; ++hh) { const bf16_t* src = QKV + (size_t)(kn + lr + 32 * hh) * QKVD + kvh * 128 + lch * 8; pk[hh] = *(const u32x4*)(src + 2048); pv[hh] = *(const u32x4*)(src + 2560); } } }
            const bool active = is_ctx || !(krow0 + 63 < q0 - 128 || krow0 > q0 + 15 + 128);
            if (active) {
                f32x4 st[4];
#pragma unroll
                for (int kt = 0; kt < 4; ++kt) { st[kt] = (f32x4){0.f, 0.f, 0.f, 0.f};
#pragma unroll
                    for (int ks = 0; ks < 4; ++ks) { const bf16x8 kf = *(const LAS bf16x8*)(Ks + (16 * kt + fr) * KP + (32 * ks + 8 * fq) * 2);
                        st[kt] = __builtin_amdgcn_mfma_f32_16x16x32_bf16(kf, Qf[ks], st[kt], 0, 0, 0); } }
                const float cs = 0.08838834764831845f * 1.4426950408889634f;
                float tmax = -INFINITY;
#pragma unroll
                for (int kt = 0; kt < 4; ++kt)
#pragma unroll
                    for (int r = 0; r < 4; ++r) { float v = st[kt][r] * cs;
                        if (!is_ctx) { const int dk = (krow0 + 16 * kt + 4 * fq + r) - (q0 + fr); if (dk > 128 || dk < -128) v = -INFINITY; }
                        st[kt][r] = v; tmax = fmaxf(tmax, v); }
                tmax = fmaxf(tmax, __shfl_xor(tmax, 16)); tmax = fmaxf(tmax, __shfl_xor(tmax, 32));
                const float mn = fmaxf(m, tmax), alpha = __builtin_amdgcn_exp2f(m - mn); m = mn;
                lpart *= alpha;
#pragma unroll
                for (int dt = 0; dt < 8; ++dt) Oacc[dt] *= alpha;
                bf16x8 pf[2];
#pragma unroll
                for (int kk = 0; kk < 2; ++kk) { float p[8];
#pragma unroll
                    for (int j = 0; j < 8; ++j) { p[j] = __builtin_amdgcn_exp2f(st[2 * kk + (j >> 2)][j & 3] - m); lpart += p[j]; }
                    u32x4 w; w.x = cvt_pk_bf16(p[0], p[1]); w.y = cvt_pk_bf16(p[2], p[3]); w.z = cvt_pk_bf16(p[4], p[5]); w.w = cvt_pk_bf16(p[6], p[7]);
                    pf[kk] = __builtin_bit_cast(bf16x8, w); }
#pragma unroll
                for (int kk = 0; kk < 2; ++kk)
#pragma unroll
                    for (int dt = 0; dt < 8; ++dt) {
                        LAS unsigned char* ap = Vs + (32 * kk + 4 * fq + (fr >> 2)) * KP + (16 * dt + 4 * (fr & 3)) * 2;
                        const s16x4 lo = __builtin_amdgcn_ds_read_tr16_b64_v4i16((LAS s16x4*)ap), hi = __builtin_amdgcn_ds_read_tr16_b64_v4i16((LAS s16x4*)(ap + 16 * KP));
                        const bf16x8 vf = {lo[0], lo[1], lo[2], lo[3], hi[0], hi[1], hi[2], hi[3]};
                        Oacc[dt] = __builtin_amdgcn_mfma_f32_16x16x32_bf16(vf, pf[kk], Oacc[dt], 0, 0, 0);
                    }
            }
        }
        float lsum = lpart; lsum += __shfl_xor(lsum, 16); lsum += __shfl_xor(lsum, 32);
        const float inv = 1.0f / lsum;
#pragma unroll
        for (int dt = 0; dt < 8; ++dt) { const f32x4 o = Oacc[dt] * inv; u32x2 w; w.x = cvt_pk_bf16(o[0], o[1]); w.y = cvt_pk_bf16(o[2], o[3]);
            *(u32x2*)(O + (size_t)(q0 + fr) * D + h * 128 + 16 * dt + 4 * fq) = w; }
    }
    __syncthreads();
}

__device__ __forceinline__ void pool_phase(const Frame& F) {
    const bf16_t* U = (const bf16_t*)(F.ws + WS_U); bf16_t* P = (bf16_t*)(F.ws + WS_GT);
    const int col = (F.tid & 255) * 8, g = col >> 9, size = 2 << g, hs = size >> 1;
    for (int rb = F.bid; rb < SEQ / 64; rb += F.G) {
        const int t0 = rb * 64 + (F.tid >> 8) * 32;
        float s[8];
#pragma unroll
        for (int e = 0; e < 8; ++e) s[e] = 0.f;
        { int lo = t0 - hs, hi = t0 + hs - 1; lo = lo < 0 ? 0 : lo; hi = hi > SEQ ? SEQ : hi;
          for (int r = lo; r < hi; ++r) { const u32x4 v = *(const u32x4*)(U + (size_t)r * D + col);
#pragma unroll
              for (int e = 0; e < 4; ++e) { s[2 * e] += bflo(v[e]); s[2 * e + 1] += bfhi(v[e]); } } }
#pragma unroll 1
        for (int tb = t0; tb < t0 + 32; tb += 8) {
            u32x4 va[8], vs[8], vc[8];
#pragma unroll
            for (int k = 0; k < 8; ++k) { const int t = tb + k; int ra = t + hs - 1; ra = ra < SEQ ? ra : SEQ - 1; int rs = t - hs - 1; rs = rs < 0 ? 0 : rs;
                va[k] = *(const u32x4*)(U + (size_t)ra * D + col); vs[k] = *(const u32x4*)(U + (size_t)rs * D + col); vc[k] = *(const u32x4*)(U + (size_t)t * D + col); }
#pragma unroll
            for (int k = 0; k < 8; ++k) { const int t = tb + k;
                const float ma = (t + hs - 1 < SEQ) ? 1.0f : 0.0f, ms = (t - hs - 1 >= 0 && t > t0) ? 1.0f : 0.0f;
#pragma unroll
                for (int e = 0; e < 4; ++e) { s[2 * e] += ma * bflo(va[k][e]); s[2 * e + 1] += ma * bfhi(va[k][e]); }
#pragma unroll
                for (int e = 0; e < 4; ++e) { s[2 * e] -= ms * bflo(vs[k][e]); s[2 * e + 1] -= ms * bfhi(vs[k][e]); }
                int lo = t - hs, hi = t + hs; lo = lo < 0 ? 0 : lo; hi = hi > SEQ ? SEQ : hi;
                const float invn = 1.0f / (float)(hi - lo);
                u32x4 o;
#pragma unroll
                for (int e = 0; e < 4; ++e) o[e] = cvt_pk_bf16(s[2 * e] * invn - bflo(vc[k][e]), s[2 * e + 1] * invn - bfhi(vc[k][e]));
                *(u32x4*)(P + (size_t)t * D + col) = o;
            }
        }
    }
}

__global__ void __launch_bounds__(NTHR, 2) fwd_kernel(Args a_unused) {
    (void)a_unused;
    {
        Frame F = mk_frame();
        volatile LAS unsigned* MISC = (volatile LAS unsigned*)(F.lds + MISC_OFF);
        for (int u = F.tid; u < (LDS_BYTES - MISC_OFF) / 4; u += NTHR) MISC[u] = 0u;
        __syncthreads();
    }
    XcdBarrier bar;
    { Frame F = mk_frame(); bar = xcd_barrier_post((unsigned*)(F.ws + WS_CTL) + CW_BAR, (volatile LAS unsigned*)(F.lds + MISC_OFF) + 8);
      if (F.tid == 0) { const unsigned x = xb_xcc_id(); const unsigned r = xb_add((unsigned*)(F.ws + WS_CTL) + CW_XRANK + 64 * x, 1u);
          volatile LAS unsigned* M = (volatile LAS unsigned*)(F.lds + MISC_OFF); M[16] = x; M[17] = r; } }
#define GRID_BAR() xcd_barrier(bar)
    unsigned lgen = 0u;
#define LOCAL_BAR() do { volatile LAS unsigned* M_ = (volatile LAS unsigned*)((LAS unsigned char*)lds_dyn() + MISC_OFF); \
        if (M_[19] != 0u && gridDim.x == 256) xcc_local_barrier((unsigned*)(WSP + WS_CTL) + CW_LBAR + 64 * M_[16], 32u, lgen); else xcd_barrier(bar); } while (0)
    STAMP(31);

    { Frame F = mk_frame(); p0_mods(F); }
    { Frame F = mk_frame(); p0_rope(F); }
    { Frame F = mk_frame(); p0_hidden(F, F.wave, 8, 2, 3); }
    GRID_BAR(); STAMP(0);
    { Frame F = mk_frame();
      if (F.tid == 0) { volatile LAS unsigned* M = (volatile LAS unsigned*)(F.lds + MISC_OFF); bool uniform = (F.G % 8) == 0;
#if defined(FORCE_NONUNIFORM)
          uniform = false;
#endif
          for (int j = 0; j < 16; ++j) { const unsigned cnt = xb_ld((unsigned*)(F.ws + WS_CTL) + CW_XRANK + 64 * j); if (j < 8 ? cnt != (unsigned)(F.G / 8) : cnt != 0u) uniform = false; }
          M[18] = uniform ? (M[16] + 8u * M[17]) : (unsigned)F.bid; M[19] = uniform ? 1u : 0u; }
      __syncthreads(); }
    if (__builtin_amdgcn_readfirstlane(threadIdx.x >> 6) < 4) { Frame F = mk_frame(); p0_convert(F, F.wave, 4, 0); }
    else { { Frame F = mk_frame(); p0_filter_td<true>(F, F.wave - 4, 4, 1024, 1152); } { Frame F = mk_frame(); p0_hidden(F, F.wave - 4, 4, 0, 2); } }
    GRID_BAR(); STAMP(1);

    constexpr int NC = 44;
    const int nmain = (int)gridDim.x - NC;
    if ((int)blockIdx.x >= nmain) {
        unsigned sgen = 0u; unsigned* const sbar = (unsigned*)(WSP + WS_CTL) + CW_SUBBAR;
#define CTX_BAR() do { sub_barrier(sbar, (unsigned)NC, sgen); STAMP(30); } while (0)
#define CTX_FRAME() mk_frame_group(nmain, NC)
#define CTX_G1(fi) do { Frame F = CTX_FRAME(); \
        pg8::Gemm g{(const bf16_t*)(F.ws + WS_U) + (size_t)SEQ * D, (const bf16_t*)(F.ws + WS_WIN) + (size_t)(fi) * 2 * DFF * D, CTX, 2 * DFF, D, D, D, 0, 0, 0, 0}; \
        pg8::StaticOrder S; S.init(g.M, g.N, F.G, F.vcu); pg8::EpiSwiGLU E{(bf16_t*)(F.ws + WS_ACT) + (size_t)SEQ * DFFP, DFFP}; \
        pg8::gemm_phase<pg8::EpiSwiGLU>(F.lds, g, S, E); } while (0)
#define CTX_G2(fi) do { Frame F = CTX_FRAME(); \
        pg8::Gemm g{(const bf16_t*)(F.ws + WS_ACT) + (size_t)SEQ * DFFP, (const bf16_t*)(F.ws + WS_WOUT) + (size_t)(fi) * WOUT_STRIDE, 11 * 256, D, 512, DFFP, DFFP, 0, 0, 1024, 1024}; \
        pg8::StaticOrder S; S.init(g.M, g.N, F.G, F.vcu); pg8::EpiBf16 E{(bf16_t*)(F.ws + WS_P), D, nullptr, nullptr, nullptr, nullptr}; \
        pg8::gemm_phase<pg8::EpiBf16>(F.lds, g, S, E); } while (0)
        { Frame F = CTX_FRAME(); thin_phase(F, 0, true); } STAMP(27); CTX_BAR();
        CTX_G1(0); STAMP(26); CTX_BAR(); CTX_G2(0); STAMP(26); CTX_BAR();
        { Frame F = CTX_FRAME(); thin_phase(F, 1, true); } STAMP(27); CTX_BAR();
        { Frame F = CTX_FRAME();
          pg8::Gemm g{(const bf16_t*)(F.ws + WS_WHIN), (const bf16_t*)(F.ws + WS_U) + (size_t)SEQ * D, 3 * D, CTX, D, D, D, 0, 0, 0, 0};
          pg8::StaticOrder S; S.init(g.M, g.N, F.G, F.vcu); pg8::EpiBf16 E{(bf16_t*)(F.ws + WS_ZT) + SEQ, MT, nullptr, IN(I_HBIN), nullptr, nullptr};
          pg8::gemm_phase<pg8::EpiBf16>(F.lds, g, S, E); }
        STAMP(26); CTX_BAR();
        { Frame F = CTX_FRAME(); hyena_conv_ctx(F, 0); } STAMP(27); CTX_BAR();
        { Frame F = CTX_FRAME(); transpose_phase(F, SEQ, CTX); } STAMP(27); CTX_BAR();
        { Frame F = CTX_FRAME();
          pg8::Gemm g{(const bf16_t*)(F.ws + WS_U) + (size_t)SEQ * D, (const bf16_t*)(F.ws + WS_WHOUT), 4 * 256, D, 512, D, D, 0, 0, 1024, 1024};
          pg8::StaticOrder S; S.init(g.M, g.N, F.G, F.vcu); pg8::EpiBf16 E{(bf16_t*)(F.ws + WS_P), D, (const float*)(F.ws + WS_BQP) + QKVD, nullptr, nullptr, nullptr};
          pg8::gemm_phase<pg8::EpiBf16>(F.lds, g, S, E); }
        STAMP(26); CTX_BAR();
        { Frame F = CTX_FRAME(); thin_phase(F, 2, true); } STAMP(27); CTX_BAR();
        CTX_G1(1); STAMP(26); CTX_BAR(); CTX_G2(1); STAMP(26); CTX_BAR();
        { Frame F = CTX_FRAME(); thin_phase(F, 3, true); } STAMP(27); CTX_BAR();
        CTX_G1(2); STAMP(26); CTX_BAR(); CTX_G2(2); STAMP(26); CTX_BAR();
        { Frame F = CTX_FRAME(); thin_phase(F, 4, true); } STAMP(27); CTX_BAR();
        { Frame F = CTX_FRAME();
          pg8::Gemm g{(const bf16_t*)(F.ws + WS_U) + (size_t)SEQ * D, (const bf16_t*)(F.ws + WS_WQKV) + (size_t)2048 * D, CTX, 1024, D, D, D, 0, 0, 0, 0};
          pg8::StaticOrder S; S.init(g.M, g.N, F.G, F.vcu); pg8::EpiBf16 E{(bf16_t*)(F.ws + WS_KVC), 1024, (const float*)(F.ws + WS_BQP) + 2048, nullptr, nullptr, nullptr};
          pg8::gemm_phase<pg8::EpiBf16>(F.lds, g, S, E); }
    } else {
        unsigned mgen = 0u; unsigned* const mbar = (unsigned*)(WSP + WS_CTL) + CW_SUBBAR + 64;
        if (__builtin_amdgcn_readfirstlane(threadIdx.x >> 6) < 4) { Frame F = mk_frame_group(0, nmain); p0_convert(F, F.wave, 4, 1); }
        else { Frame F = mk_frame_group(0, nmain); p0_filter_td<false>(F, F.wave - 4, 4, 0, 1024); }
        sub_barrier(mbar, (unsigned)nmain, mgen); STAMP(28);
        { Frame F = mk_frame_group(0, nmain); p0_filter_fft(F); __syncthreads(); }
        STAMP(2);
        { Frame F = mk_frame_group(0, nmain); thin_phase(F, 0, false); }
    }
    GRID_BAR(); STAMP(29);

    for (int ph = 0; ph < 12; ++ph) {
        if (ph > 0) {
        { Frame F = mk_frame(); thin_phase(F, ph, false); }
        if (ph % 3 != 1) LOCAL_BAR(); else GRID_BAR();
        }
        STAMP(3);
        const int l = ph / 3, k = ph % 3, kind = l % 3, mj = l / 3;
        if (k != 1) {
            const int fi = l * 2 + (k >> 1);
            { Frame F = mk_frame();
              pg8::Gemm g{(const bf16_t*)(F.ws + WS_U), (const bf16_t*)(F.ws + WS_WIN) + (size_t)fi * 2 * DFF * D, SEQ, 2 * DFF, D, D, D, 0, 0, 0, 0};
              pg8::StaticOrder S; S.init(g.M, g.N, F.G, F.vcu);
              pg8::EpiSwiGLU E{(bf16_t*)(F.ws + WS_ACT), DFFP};
              pg8::gemm_phase<pg8::EpiSwiGLU>(F.lds, g, S, E, 22); }
            LOCAL_BAR(); STAMP(4);
        } else {
            if (kind != 2) {
                Frame F = mk_frame();
                pg8::Gemm g; pg8::EpiBf16 E;
                if (kind == 0) { g = pg8::Gemm{(const bf16_t*)(F.ws + WS_WHIN) + (size_t)mj * 3 * D * D, (const bf16_t*)(F.ws + WS_U), 3 * D, SEQ, D, D, D, 0, 0, 0, 0};
                    E = pg8::EpiBf16{(bf16_t*)(F.ws + WS_ZT), MT, nullptr, IN(I_HBIN) + (size_t)mj * 3 * D, nullptr, nullptr}; }
                else { g = pg8::Gemm{(const bf16_t*)(F.ws + WS_U), (const bf16_t*)(F.ws + WS_WQKV), SEQ, QKVD, D, D, D, 0, 0, 0, 0};
                    E = pg8::EpiBf16{(bf16_t*)(F.ws + WS_ZT), QKVD, (const float*)(F.ws + WS_BQP), nullptr, nullptr, (const f32x2*)(F.ws + WS_ROPE)}; }
                pg8::StaticOrder S; S.init(g.M, g.N, F.G, F.vcu);
                pg8::gemm_phase<pg8::EpiBf16>(F.lds, g, S, E);
            }
            if (kind != 2) { GRID_BAR(); STAMP(kind == 0 ? 6 : 10); }
            if (kind == 0) {
                { Frame F = mk_frame(); hyena_conv_phase(F, mj, mj); }
                GRID_BAR(); STAMP(7);
                { Frame F = mk_frame(); transpose_phase(F, 0, SEQ); }
                GRID_BAR(); STAMP(8);
            } else if (kind == 1) {
                { Frame F = mk_frame(); attn_phase(F); }
                GRID_BAR(); STAMP(12);
            } else {
                { Frame F = mk_frame(); pool_phase(F); }
                GRID_BAR(); STAMP(14);
            }
        }
        { Frame F = mk_frame();
          pg8::Gemm gF; pg8::EpiBf16 eF;
          if (k != 1) { const int fi = l * 2 + (k >> 1);
              gF = pg8::Gemm{(const bf16_t*)(F.ws + WS_ACT), (const bf16_t*)(F.ws + WS_WOUT) + (size_t)fi * WOUT_STRIDE, SEQ, D, DFF, DFFP, DFFP, 0, 0, 0, 0};
              eF = pg8::EpiBf16{(bf16_t*)(F.ws + WS_Y), D, nullptr, nullptr, nullptr, nullptr}; }
          else if (kind == 0) { gF = pg8::Gemm{(const bf16_t*)(F.ws + WS_U), (const bf16_t*)(F.ws + WS_WHOUT) + (size_t)mj * D * D, SEQ, D, D, D, D, 0, 0, 0, 0};
              eF = pg8::EpiBf16{(bf16_t*)(F.ws + WS_Y), D, IN(I_HBOUT) + (size_t)mj * D, nullptr, nullptr, nullptr}; }
          else if (kind == 1) { gF = pg8::Gemm{(const bf16_t*)(F.ws + WS_U), (const bf16_t*)(F.ws + WS_WO), SEQ, D, D, D, D, 0, 0, 0, 0};
              eF = pg8::EpiBf16{(bf16_t*)(F.ws + WS_Y), D, IN(I_ABO), nullptr, nullptr, nullptr}; }
          else { gF = pg8::Gemm{(const bf16_t*)(F.ws + WS_GT), (const bf16_t*)(F.ws + WS_WP), SEQ, D, 512, D, 512, 1, 512, 0, 0};
              eF = pg8::EpiBf16{(bf16_t*)(F.ws + WS_Y), D, IN(I_PB), nullptr, IN(I_PSCALE), nullptr}; }
          pg8::StaticOrder S; S.init(gF.M, gF.N, F.G, F.vcu);
          pg8::gemm_phase<pg8::EpiBf16>(F.lds, gF, S, eF, (k != 1) ? 24 : -1);
        }
        LOCAL_BAR(); STAMP(k != 1 ? 5 : (kind == 0 ? 9 : (kind == 1 ? 13 : 15)));
    }
    { Frame F = mk_frame(); thin_phase(F, 12, false); }
    STAMP(3);
#if defined(DIAG_MASK)
    if (blockIdx.x == DIAG_BLK && threadIdx.x == 0) {
        extern __shared__ __attribute__((aligned(16))) unsigned char lds_raw[];
        volatile LAS unsigned long long* ta = (volatile LAS unsigned long long*)((LAS unsigned char*)lds_raw + MISC_OFF + 256);
        unsigned long long tot = 0ull;
        for (int c = 0; c < 32; ++c) if (((unsigned long long)(DIAG_MASK) >> c) & 1ull) tot += ta[1 + c];
        OUTP[(size_t)(DIAG_BLK * 8) * D] += (float)tot * 0.0001f;
    }
#endif
}

static_assert(offsetof(Args, out) == 8 * 33 && offsetof(Args, ws) == 8 * 34 && offsetof(Args, invf) == 8 * 35 && sizeof(Args) == 8 * 67, "kernarg layout");
extern "C" void kernel_launch(void* const* d_in, const int* in_sizes, int n_in, void* d_out, int out_size, void* d_ws, size_t ws_size, hipStream_t stream) {
    static int grid = 0;
    if (grid == 0) {
        if (n_in != 33 || out_size != SEQ * D || ws_size < WS_END) { fprintf(stderr, "kernel_launch: unexpected problem: n_in %d out %d ws %zu (need %zu)\n", n_in, out_size, ws_size, (size_t)WS_END); grid = -1; return; }
        int dev = 0, cus = 0, per_cu = 0;
        if (hipGetDevice(&dev) != hipSuccess || hipDeviceGetAttribute(&cus, hipDeviceAttributeMultiprocessorCount, dev) != hipSuccess) { grid = -1; return; }
        if (hipFuncSetAttribute((const void*)fwd_kernel, hipFuncAttributeMaxDynamicSharedMemorySize, LDS_BYTES) != hipSuccess) { fprintf(stderr, "kernel_launch: hipFuncSetAttribute failed\n"); grid = -1; return; }
        if (hipOccupancyMaxActiveBlocksPerMultiprocessor(&per_cu, (const void*)fwd_kernel, NTHR, LDS_BYTES) != hipSuccess || per_cu < 1) fprintf(stderr, "kernel_launch: occupancy query says %d\n", per_cu);
        (void)hipGetLastError();
        grid = cus;
    }
    if (grid < 0) return;
    (void)in_sizes;
    if (hipMemsetAsync((char*)d_ws + WS_CTL, 0, CTL_ZERO_BYTES, stream) != hipSuccess) { fprintf(stderr, "kernel_launch: memset failed\n"); return; }
    Args a{};
    for (int i = 0; i < 33; ++i) a.in[i] = (const float*)d_in[i];
    a.out = (float*)d_out; a.ws = (unsigned char*)d_ws;
    for (int j = 0; j < 32; ++j) a.invf[j] = std::pow(10000.0, -(double)j / 32.0);
    hipLaunchKernelGGL(fwd_kernel, dim3(grid), dim3(NTHR), LDS_BYTES, stream, a);
    const hipError_t le = hipPeekAtLastError();
    if (le != hipSuccess) fprintf(stderr, "kernel_launch: launch failed: %s\n", hipGetErrorName(le));
}
```

```cpp
#include <hip/hip_runtime.h>
#include <cstdio>
#include <cstdint>
#include <cmath>
#include <cstddef>

#define LAS __attribute__((address_space(3)))
#define GAS __attribute__((address_space(1)))
#define CAS __attribute__((address_space(4)))
typedef unsigned short bf16_t;
typedef short bf16x8 __attribute__((ext_vector_type(8)));
typedef float f32x4 __attribute__((ext_vector_type(4)));
typedef float f32x2 __attribute__((ext_vector_type(2)));
typedef unsigned u32x4 __attribute__((ext_vector_type(4)));
typedef unsigned u32x2 __attribute__((ext_vector_type(2)));
typedef _Float16 f16x4 __attribute__((ext_vector_type(4)));

constexpr int D = 2048, SEQ = 16384, CTX = 256, MT = SEQ + CTX, DEPTH = 4, DFF = 5632, NMOD = 9, QKVD = 3072;
constexpr int DFFP = DFF + 64;
constexpr int NWAVES = 8, NTHR = 512;
constexpr float NORM_EPS = 1e-6f;

constexpr size_t MiB = 1u << 20;
constexpr size_t WS_CTL = 0, CTL_ZERO_BYTES = 1 * MiB;
constexpr size_t WS_MOD = 1 * MiB;
constexpr size_t WS_ROPE = 2 * MiB;
constexpr size_t WS_HID = 3 * MiB;
constexpr size_t WS_FILTC = 15 * MiB;
constexpr size_t WS_FILT = 19 * MiB;
constexpr size_t WS_WIN = WS_FILT + 512 * MiB;
constexpr size_t WS_WOUT = WS_WIN + 352 * MiB;
constexpr size_t WOUT_STRIDE = 23 * MiB / 2;
constexpr size_t WS_WHIN = WS_WOUT + 184 * MiB;
constexpr size_t WS_WHOUT = WS_WHIN + 48 * MiB;
constexpr size_t WS_WQKV = WS_WHOUT + 16 * MiB;
constexpr size_t WS_WO = WS_WQKV + 12 * MiB;
constexpr size_t WS_WP = WS_WO + 8 * MiB;
constexpr size_t WS_H = WS_WP + 2 * MiB;
constexpr size_t WS_U = WS_H + 130 * MiB;
constexpr size_t WS_ACT = WS_U + 65 * MiB;
constexpr size_t WS_Y = WS_ACT + 182 * MiB;
constexpr size_t WS_ZT = WS_Y + 130 * MiB;
constexpr size_t WS_GT = WS_ZT + 195 * MiB;
constexpr size_t WS_P = WS_GT + 65 * MiB;
constexpr size_t WS_END = WS_P + 12 * MiB;
constexpr size_t WS_KVC = WS_ROPE + 131072;
constexpr size_t WS_BQP = WS_ROPE + 65536;
constexpr int CW_TMO = 0;
constexpr int CW_BAR = 4096;
constexpr int CW_LBAR = 3072;
constexpr int CW_SUBBAR = 2048;
constexpr int CW_XRANK = 1024;

constexpr int LDS_SCRATCH = 143360;
constexpr int MISC_OFF = LDS_SCRATCH;
constexpr int LDS_BYTES = 151552;

__device__ __forceinline__ unsigned cvt_pk_bf16(float lo, float hi) { unsigned r; asm volatile("v_cvt_pk_bf16_f32 %0, %1, %2" : "=v"(r) : "v"(lo), "v"(hi)); return r; }
__device__ __forceinline__ float bf2f(unsigned short b) { return __uint_as_float(((unsigned)b) << 16); }
__device__ __forceinline__ float bflo(unsigned w) { return __uint_as_float(w << 16); }
__device__ __forceinline__ float bfhi(unsigned w) { return __uint_as_float(w & 0xffff0000u); }
__device__ __forceinline__ bf16_t f2bf(float f) { return (bf16_t)(cvt_pk_bf16(f, 0.f) & 0xffffu); }
__device__ __forceinline__ float wave_sum(float v) {
#pragma unroll
    for (int o = 1; o < 64; o <<= 1) v += __shfl_xor(v, o);
    return v;
}
__device__ __forceinline__ float silu_f(float x) { return x * __builtin_amdgcn_rcpf(1.f + __builtin_amdgcn_exp2f(-1.4426950408889634f * x)); }
#define LDS_WAIT() asm volatile("s_waitcnt lgkmcnt(0)" ::: "memory")
#define VM_WAIT() asm volatile("s_waitcnt vmcnt(0)" ::: "memory")

#if defined(DIAG_MASK) && defined(DIAG_GEMM)
__device__ __forceinline__ void diag_stamp(int cls);
#define GSTAMP(c) do { if ((c) >= 0) diag_stamp(c); } while (0)
#else
#define GSTAMP(c) do { } while (0)
#endif
namespace pg8 {
constexpr int BM = 256, BK = 64, HALF = 128, HTB = HALF * BK * 2, STAGE_BYTES = 8 * HTB, NXCD = 8, WGM = 8;
__host__ __device__ __forceinline__ int lds_byte(int r, int c) { const int st = (r >> 4) * 2 + (c >> 5), rr = r & 15, cc = c & 31, ob = rr * 64 + cc * 2; return st * 1024 + (ob ^ (((ob >> 9) & 1) << 5)); }
__host__ __device__ __forceinline__ void stage_rc(int b, int& R, int& C) { const int st = b / 1024, sb = b % 1024, swz = sb ^ (((sb >> 9) & 1) << 5); R = (st >> 1) * 16 + swz / 64; C = (st & 1) * 32 + (swz % 64) / 2; }
__host__ __device__ __forceinline__ int perm32(int rho) { const int n = rho >> 4, i = rho & 15; return 8 * (i >> 2) + 4 * n + (i & 3); }

struct Unit { int pm, pn; };
struct Gemm { const bf16_t* A; const bf16_t* Bt; int M, N, K, lda, ldb, a_shift, a_step; size_t a_pm, b_pm; };

struct StaticOrder {
    int nM, nN, nwg, G, c;
    __device__ void init(int M, int N, int G_, int c_) { nM = M / BM; nN = N / BM; nwg = nM * nN; G = G_; c = c_; }
    __device__ bool next(int i, Unit& u) const {
        const long L = (long)i * G + c; if (L >= nwg) return false;
        int wgid = (int)L; { const int q = nwg / NXCD, r = nwg % NXCD, xcd = wgid % NXCD, off = wgid / NXCD; wgid = (xcd < r ? xcd * (q + 1) : r * (q + 1) + (xcd - r) * q) + off; }
        const int nig = WGM * nN, gid = wgid / nig, fm = gid * WGM, gsz = (nM - fm) < WGM ? (nM - fm) : WGM;
        u.pm = fm + ((wgid % nig) % gsz); u.pn = (wgid % nig) / gsz; return true;
    }
};

struct EpiSwiGLU {
    static constexpr bool PERM = true;
    bf16_t* O; int ldc;
    __device__ __forceinline__ void operator()(const f32x4 (&acc)[2][2][4][2], const Unit& u, int wr, int wc, int fr, int fq) const {
        const int row0 = u.pm * BM + wr * 64 + fr, col0 = u.pn * HALF + wc * 32 + 8 * fq;
#pragma unroll
        for (int ai = 0; ai < 2; ++ai)
#pragma unroll
            for (int m = 0; m < 4; ++m) { bf16_t* rowp = O + (size_t)(row0 + ai * HALF + m * 16) * ldc + col0;
                const f32x4 g0 = acc[ai][0][m][0], g1 = acc[ai][0][m][1], u0 = acc[ai][1][m][0], u1 = acc[ai][1][m][1];
                u32x4 w;
                w.x = cvt_pk_bf16(silu_f(g0[0]) * u0[0], silu_f(g0[1]) * u0[1]); w.y = cvt_pk_bf16(silu_f(g0[2]) * u0[2], silu_f(g0[3]) * u0[3]);
                w.z = cvt_pk_bf16(silu_f(g1[0]) * u1[0], silu_f(g1[1]) * u1[1]); w.w = cvt_pk_bf16(silu_f(g1[2]) * u1[2], silu_f(g1[3]) * u1[3]);
#if !defined(DIAG_NO_EPI_STORE)
                *(u32x4*)rowp = w;
#else
                if (w.x == 0x12345678u) *(u32x4*)rowp = w;
#endif
                }
    }
};
struct EpiF32 {
    static constexpr bool PERM = false;
    float* C; int ldc; const float* bias; const float* scale;
    __device__ __forceinline__ void operator()(const f32x4 (&acc)[2][2][4][2], const Unit& u, int wr, int wc, int fr, int fq) const {
        const int row0 = u.pm * BM + wr * 64 + fr, col0 = u.pn * BM + wc * 32 + 4 * fq;
        f32x4 bv[2][2], sv[2][2];
#pragma unroll
        for (int bj = 0; bj < 2; ++bj)
#pragma unroll
            for (int n = 0; n < 2; ++n) { bv[bj][n] = bias ? *(const f32x4*)(bias + col0 + bj * HALF + n * 16) : (f32x4){0.f, 0.f, 0.f, 0.f};
                sv[bj][n] = scale ? *(const f32x4*)(scale + col0 + bj * HALF + n * 16) : (f32x4){1.f, 1.f, 1.f, 1.f}; }
#pragma unroll
        for (int ai = 0; ai < 2; ++ai)
#pragma unroll
            for (int m = 0; m < 4; ++m) { float* rowp = C + (size_t)(row0 + ai * HALF + m * 16) * ldc + col0;
#pragma unroll
                for (int bj = 0; bj < 2; ++bj)
#pragma unroll
                    for (int n = 0; n < 2; ++n) *(f32x4*)(rowp + bj * HALF + n * 16) = (acc[ai][bj][m][n] + bv[bj][n]) * sv[bj][n]; }
    }
};
struct EpiBf16 {
    static constexpr bool PERM = true;
    bf16_t* O; int ldc; const float* cbias; const float* rbias; const float* cscale; const f32x2* rope;
    __device__ __forceinline__ void operator()(const f32x4 (&acc)[2][2][4][2], const Unit& u, int wr, int wc, int fr, int fq) const {
        const int row0 = u.pm * BM + wr * 64 + fr, col0 = u.pn * BM + wc * 32 + 8 * fq;
        f32x4 bv[2][2], sv[2][2];
#pragma unroll
        for (int bj = 0; bj < 2; ++bj)
#pragma unroll
            for (int n = 0; n < 2; ++n) { bv[bj][n] = cbias ? *(const f32x4*)(cbias + col0 + bj * HALF + 4 * n) : (f32x4){0.f, 0.f, 0.f, 0.f};
                sv[bj][n] = cscale ? *(const f32x4*)(cscale + col0 + bj * HALF + 4 * n) : (f32x4){1.f, 1.f, 1.f, 1.f}; }
        const bool do_rope = rope != nullptr && u.pn < 10 && u.pm < 64;
#pragma unroll
        for (int ai = 0; ai < 2; ++ai)
#pragma unroll
            for (int m = 0; m < 4; ++m) { const int row = row0 + ai * HALF + m * 16; bf16_t* rowp = O + (size_t)row * ldc + col0; const float rb = rbias ? rbias[row] : 0.f;
#pragma unroll
                for (int bj = 0; bj < 2; ++bj) { f32x4 v0 = (acc[ai][bj][m][0] + bv[bj][0] + rb) * sv[bj][0], v1 = (acc[ai][bj][m][1] + bv[bj][1] + rb) * sv[bj][1];
                    if (do_rope) { const int e0 = (col0 + bj * HALF) & 127, pos = (e0 < 64) ? (row >> 6) : (row & 63);
                        const f32x4* tb = (const f32x4*)(rope + pos * 32 + ((e0 & 63) >> 1)); const f32x4 c0 = tb[0], c1 = tb[1];
                        v0 = (f32x4){v0[0] * c0[0] - v0[1] * c0[1], v0[1] * c0[0] + v0[0] * c0[1], v0[2] * c0[2] - v0[3] * c0[3], v0[3] * c0[2] + v0[2] * c0[3]};
                        v1 = (f32x4){v1[0] * c1[0] - v1[1] * c1[1], v1[1] * c1[0] + v1[0] * c1[1], v1[2] * c1[2] - v1[3] * c1[3], v1[3] * c1[2] + v1[2] * c1[3]}; }
                    u32x4 w; w.x = cvt_pk_bf16(v0[0], v0[1]); w.y = cvt_pk_bf16(v0[2], v0[3]); w.z = cvt_pk_bf16(v1[0], v1[1]); w.w = cvt_pk_bf16(v1[2], v1[3]);
                    *(u32x4*)(rowp + bj * HALF) = w; } }
    }
};

template <class Epi>
__device__ __forceinline__ void gemm_phase(LAS unsigned char* lds, const Gemm g, const StaticOrder& S, const Epi& E, int dcls = -1) {
    int tid_ = threadIdx.x; asm volatile("" : "+v"(tid_));
    const int tid = tid_, wid = __builtin_amdgcn_readfirstlane(tid >> 6), lane = tid & 63, wr = wid >> 2, wc = wid & 3, fr = lane & 15, fq = lane >> 4;
    const int K = g.K, nt = K / BK;
    unsigned voffA[2], voffB[2];
#pragma unroll
    for (int i = 0; i < 2; ++i) { int R, C; stage_rc(tid * 16 + i * 8192, R, C); const int Rb = Epi::PERM ? ((R & ~31) + perm32(R & 31)) : R;
        voffA[i] = (unsigned)(R * g.lda + C) * 2u; voffB[i] = (unsigned)(Rb * g.ldb + C) * 2u; }
    const size_t kstep = (size_t)(BK * 2);
    const size_t hstepA = (size_t)HALF * g.lda * 2, hstepB = (size_t)HALF * g.ldb * 2;
    const size_t tstepA = g.a_pm ? g.a_pm : 2 * hstepA, tstepB = 2 * hstepB;
    const unsigned ldsw = (unsigned)wid * 1024u;
    const int aoff = lds_byte(wr * 64 + fr, fq * 8), boff = lds_byte(wc * 32 + fr, fq * 8);
#define PG8_SA(b, h) (((b) * 2 + (h)) * HTB)
#define PG8_SB(b, h) ((4 + (b) * 2 + (h)) * HTB)
#define PG8_STAGE(bufoff, gbase, voff) do { _Pragma("unroll") for (int _i = 0; _i < 2; ++_i) \
        __builtin_amdgcn_global_load_lds((const unsigned*)((const char*)(gbase) + (voff)[_i]), (LAS unsigned*)(lds + (bufoff) + ldsw + _i * 8192), 16, 0, 0); } while (0)
#define PG8_LDA(dst, b, h) do { _Pragma("unroll") for (int m = 0; m < 4; ++m) _Pragma("unroll") for (int k = 0; k < 2; ++k) dst[m][k] = *(const LAS bf16x8*)(lds + PG8_SA(b, h) + aoff + m * 2048 + k * 1024); } while (0)
#define PG8_LDB(dst, b, h) do { _Pragma("unroll") for (int n = 0; n < 2; ++n) _Pragma("unroll") for (int k = 0; k < 2; ++k) dst[n][k] = *(const LAS bf16x8*)(lds + PG8_SB(b, h) + boff + n * 2048 + k * 1024); } while (0)
#define PG8_MMA(ai, bj, At, Bt) do { __builtin_amdgcn_s_setprio(1); _Pragma("unroll") for (int m = 0; m < 4; ++m) _Pragma("unroll") for (int n = 0; n < 2; ++n) _Pragma("unroll") for (int k = 0; k < 2; ++k) \
        acc[ai][bj][m][n] = __builtin_amdgcn_mfma_f32_16x16x32_bf16(Bt[n][k], At[m][k], acc[ai][bj][m][n], 0, 0, 0); __builtin_amdgcn_s_setprio(0); } while (0)
#define PG8_WAIT_V(n) asm volatile("s_waitcnt vmcnt(" #n ")" ::: "memory")
#define PG8_WAIT_L(n) asm volatile("s_waitcnt lgkmcnt(" #n ")" ::: "memory")
#define PG8_BAR __builtin_amdgcn_s_barrier()
#define PG8_SCHED __builtin_amdgcn_sched_barrier(0)
    Unit cur, nxt; int ui = 0;
    if (!S.next(0, cur)) return;
    f32x4 acc[2][2][4][2];
#pragma unroll
    for (int a = 0; a < 2; ++a)
#pragma unroll
        for (int b = 0; b < 2; ++b)
#pragma unroll
            for (int m = 0; m < 4; ++m)
#pragma unroll
                for (int n = 0; n < 2; ++n) acc[a][b][m][n] = (f32x4){0.f, 0.f, 0.f, 0.f};
    bf16x8 At[4][2], B0[2][2], B1[2][2];
    const char* cA = (const char*)g.A + (size_t)cur.pm * tstepA + (size_t)((cur.pn >> g.a_shift) * g.a_step) * 2; const char* cB = (const char*)g.Bt + (size_t)cur.pn * tstepB + (size_t)cur.pm * g.b_pm;
    PG8_STAGE(PG8_SB(0, 0), cB, voffB); PG8_STAGE(PG8_SB(0, 1), cB + hstepB, voffB); PG8_STAGE(PG8_SA(0, 0), cA, voffA); PG8_STAGE(PG8_SA(0, 1), cA + hstepA, voffA);
    if (wr == 1) PG8_BAR;
    PG8_WAIT_V(2); PG8_BAR;
    PG8_STAGE(PG8_SB(1, 0), cB + kstep, voffB); PG8_STAGE(PG8_SA(1, 0), cA + kstep, voffA); PG8_STAGE(PG8_SB(1, 1), cB + hstepB + kstep, voffB);
    PG8_WAIT_V(6); PG8_BAR;
    for (;;) {
        const bool has_next = S.next(ui + 1, nxt);
        const char* nA = has_next ? (const char*)g.A + (size_t)nxt.pm * tstepA + (size_t)((nxt.pn >> g.a_shift) * g.a_step) * 2 : cA; const char* nB = has_next ? (const char*)g.Bt + (size_t)nxt.pn * tstepB + (size_t)nxt.pm * g.b_pm : cB;
        for (int t = 0; t < nt; t += 2) {
            const bool last = (t == nt - 2);
            const char* a1 = cA + (size_t)(t + 1) * kstep;
            const char* a2 = last ? nA : cA + (size_t)(t + 2) * kstep; const char* b2 = last ? nB : cB + (size_t)(t + 2) * kstep;
            const char* a3 = a2 + kstep; const char* b3 = b2 + kstep;
            PG8_LDB(B0, 0, 0); PG8_LDB(B1, 0, 1); PG8_SCHED; PG8_LDA(At, 0, 0); PG8_STAGE(PG8_SA(1, 1), a1 + hstepA, voffA);
            PG8_WAIT_V(8); PG8_WAIT_L(0); PG8_BAR; PG8_MMA(0, 0, At, B0); PG8_MMA(0, 1, At, B1); PG8_BAR; PG8_SCHED;
            PG8_LDA(At, 0, 1); PG8_STAGE(PG8_SB(0, 0), b2, voffB); PG8_STAGE(PG8_SB(0, 1), b2 + hstepB, voffB); PG8_STAGE(PG8_SA(0, 0), a2, voffA);
            PG8_WAIT_V(8); PG8_WAIT_L(0); PG8_BAR; PG8_MMA(1, 0, At, B0); PG8_MMA(1, 1, At, B1); PG8_BAR; PG8_SCHED;
            PG8_LDB(B0, 1, 0); PG8_LDB(B1, 1, 1); PG8_SCHED; PG8_LDA(At, 1, 0); PG8_STAGE(PG8_SA(0, 1), a2 + hstepA, voffA);
            PG8_WAIT_V(8); PG8_WAIT_L(0); PG8_BAR; PG8_MMA(0, 0, At, B0); PG8_MMA(0, 1, At, B1); PG8_BAR; PG8_SCHED;
            PG8_LDA(At, 1, 1); PG8_STAGE(PG8_SB(1, 0), b3, voffB); PG8_STAGE(PG8_SB(1, 1), b3 + hstepB, voffB); PG8_STAGE(PG8_SA(1, 0), a3, voffA);
            PG8_WAIT_V(8); PG8_WAIT_L(0); PG8_BAR; PG8_MMA(1, 0, At, B0); PG8_MMA(1, 1, At, B1); PG8_BAR; PG8_SCHED;
        }
        if (wr == 0) PG8_BAR;
        GSTAMP(dcls);
        E(acc, cur, wr, wc, fr, fq);
        GSTAMP(dcls >= 0 ? dcls + 1 : -1);
        if (!has_next) break;
#pragma unroll
        for (int a = 0; a < 2; ++a)
#pragma unroll
            for (int b = 0; b < 2; ++b)
#pragma unroll
                for (int m = 0; m < 4; ++m)
#pragma unroll
                    for (int n = 0; n < 2; ++n) acc[a][b][m][n] = (f32x4){0.f, 0.f, 0.f, 0.f};
        cur = nxt; cA = nA; cB = nB; ++ui;
        if (wr == 1) PG8_BAR;
    }
    PG8_WAIT_V(0);
    PG8_BAR;
#undef PG8_SA
#undef PG8_SB
#undef PG8_STAGE
#undef PG8_LDA
#undef PG8_LDB
#undef PG8_MMA
#undef PG8_WAIT_V
#undef PG8_WAIT_L
#undef PG8_BAR
#undef PG8_SCHED
}
}

#define XB_TMO      128
#define XB_XCNT(j)  (256  + 64 * (j))
#define XB_XSUB(j)  (1280 + 64 * (j))
#define XB_XGEN(j)  (2304 + 64 * (j))
#define XB_TOP      3328
#define XB_TOPGEN   3392
#define XCD_BAR_WORDS 3456
#define XB_SPIN_CAP (1u << 18)
__device__ __forceinline__ unsigned xb_ld(unsigned* p)              { return __hip_atomic_load(p, __ATOMIC_RELAXED, __HIP_MEMORY_SCOPE_AGENT); }
__device__ __forceinline__ unsigned xb_add(unsigned* p, unsigned v) { return __hip_atomic_fetch_add(p, v, __ATOMIC_RELAXED, __HIP_MEMORY_SCOPE_AGENT); }
__device__ __forceinline__ unsigned xb_xcc_id() { return (unsigned)__builtin_amdgcn_s_getreg((3 << 11) | 20) & 0xFu; }
#define XB_SPIN(cond, bar) do { unsigned _sp = 0; while (cond) { __builtin_amdgcn_s_sleep(1); \
    if ((++_sp & 255u) == 0u) { if (xb_ld(&(bar)[XB_TMO])) break; if (_sp > XB_SPIN_CAP) { atomicAdd(&(bar)[XB_TMO], 1u); break; } } } } while (0)
struct XcdBarrier { unsigned* bar; unsigned x; volatile LAS unsigned* st; };
__device__ __forceinline__ XcdBarrier xcd_barrier_post(unsigned* bar, volatile LAS unsigned* st) {
    XcdBarrier b; b.bar = bar; b.x = xb_xcc_id(); b.st = st;
    if (threadIdx.x == 0) (void)xb_add(&bar[XB_XCNT(b.x)], 1u);
    return b;
}
__device__ __forceinline__ void xcd_barrier_complete(unsigned* bar, unsigned x, unsigned& nloc, unsigned& nx) {
    const unsigned G = gridDim.x * gridDim.y * gridDim.z;
    unsigned sum, cnt, mine, sp = 0u;
    for (;;) {
        sum = 0u; cnt = 0u; mine = 0u;
#pragma unroll
        for (unsigned j = 0; j < 16; ++j) { const unsigned c = xb_ld(&bar[XB_XCNT(j)]); sum += c; cnt += (c > 0u) ? 1u : 0u; mine = (j == x) ? c : mine; }
        if (sum == G) break;
        __builtin_amdgcn_s_sleep(1);
        if ((++sp & 255u) == 0u) { if (xb_ld(&bar[XB_TMO])) break; if (sp > XB_SPIN_CAP) { atomicAdd(&bar[XB_TMO], 1u); break; } }
    }
    nloc = mine > 0u ? mine : 1u; nx = cnt > 0u ? cnt : 1u;
}
__device__ __forceinline__ void xcd_barrier(const XcdBarrier& b) {
    asm volatile("s_waitcnt vmcnt(0)" ::: "memory");
    __syncthreads();
    if (threadIdx.x == 0) {
        unsigned* bar = b.bar;
        __builtin_amdgcn_s_waitcnt(0);
        unsigned nloc = b.st[0], nx = b.st[1];
        if (nloc == 0u) { xcd_barrier_complete(bar, b.x, nloc, nx); b.st[0] = nloc; b.st[1] = nx; }
        const unsigned old = xb_add(&bar[XB_XSUB(b.x)], 1u);
        const unsigned gen = old / nloc;
        if (old + 1u == (gen + 1u) * nloc) {
            __builtin_amdgcn_fence(__ATOMIC_RELEASE, "agent");
            asm volatile("s_waitcnt vmcnt(0)" ::: "memory");
            const unsigned og = xb_add(&bar[XB_TOP], 1u);
            const unsigned tg = og / nx;
            if (og + 1u == (tg + 1u) * nx) xb_add(&bar[XB_TOPGEN], 1u);
            else XB_SPIN(xb_ld(&bar[XB_TOPGEN]) == tg, bar);
            __builtin_amdgcn_fence(__ATOMIC_ACQUIRE, "agent");
            xb_add(&bar[XB_XGEN(b.x)], 1u);
            asm volatile("s_waitcnt vmcnt(0)" ::: "memory");
        } else {
            XB_SPIN(xb_ld(&bar[XB_XGEN(b.x)]) == gen, bar);
            __builtin_amdgcn_fence(__ATOMIC_ACQUIRE, "agent");
            asm volatile("s_waitcnt vmcnt(0)" ::: "memory");
        }
    }
    __syncthreads();
}

__device__ __forceinline__ void xcc_local_barrier(unsigned* cnt, unsigned n, unsigned& gen) {
    asm volatile("s_waitcnt vmcnt(0)" ::: "memory");
    __syncthreads();
    if (threadIdx.x == 0) {
        (void)xb_add(cnt, 1u);
        const unsigned target = (gen + 1u) * n; unsigned sp = 0u;
        while (xb_ld(cnt) < target) { __builtin_amdgcn_s_sleep(1); if (++sp > XB_SPIN_CAP) break; }
        __builtin_amdgcn_fence(__ATOMIC_ACQUIRE, "agent");
        asm volatile("s_waitcnt vmcnt(0)" ::: "memory");
    }
    __syncthreads();
    ++gen;
}
__device__ __forceinline__ void sub_barrier(unsigned* cnt, unsigned n, unsigned& gen) {
    asm volatile("s_waitcnt vmcnt(0)" ::: "memory");
    __syncthreads();
    if (threadIdx.x == 0) {
        __builtin_amdgcn_fence(__ATOMIC_RELEASE, "agent");
        asm volatile("s_waitcnt vmcnt(0)" ::: "memory");
        (void)xb_add(cnt, 1u);
        const unsigned target = (gen + 1u) * n; unsigned sp = 0u;
        while (xb_ld(cnt) < target) { __builtin_amdgcn_s_sleep(1); if (++sp > XB_SPIN_CAP) break; }
        __builtin_amdgcn_fence(__ATOMIC_ACQUIRE, "agent");
        asm volatile("s_waitcnt vmcnt(0)" ::: "memory");
    }
    __syncthreads();
    ++gen;
}

#define FD __device__ __forceinline__
FD float hw_sin_rev(float f) { return __builtin_amdgcn_sinf(f); }
FD float hw_cos_rev(float f) { return __builtin_amdgcn_cosf(f); }
FD unsigned bitrev32(unsigned v) { return __builtin_bitreverse32(v); }
namespace fftc {
typedef float cf __attribute__((ext_vector_type(2)));
constexpr int LOGM = 14, FM = 1 << LOGM;
constexpr int FPHYS = FM + (FM >> 4) + ((FM >> 9) << 4);
FD int phys(int i) { return i + (i >> 4) + ((i >> 9) << 4); }
FD cf cmul(cf a, cf b) { return a.xx * b + a.yy * (cf){-b.y, b.x}; }
FD cf cmulp(cf a, cf w, cf wp) { return a.xx * w + a.yy * wp; }
FD cf cperp(cf w) { return (cf){-w.y, w.x}; }
FD cf cconj(cf a) { return (cf){a.x, -a.y}; }
FD cf c32(int m) {
    constexpr float C[16] = {1.0f, 0.9807852804032304f, 0.9238795325112867f, 0.8314696123025452f, 0.7071067811865476f, 0.5555702330196022f, 0.3826834323650898f, 0.19509032201612825f,
                             0.0f, -0.19509032201612825f, -0.3826834323650898f, -0.5555702330196022f, -0.7071067811865476f, -0.8314696123025452f, -0.9238795325112867f, -0.9807852804032304f};
    constexpr float S[16] = {0.0f, 0.19509032201612825f, 0.3826834323650898f, 0.5555702330196022f, 0.7071067811865476f, 0.8314696123025452f, 0.9238795325112867f, 0.9807852804032304f,
                             1.0f, 0.9807852804032304f, 0.9238795325112867f, 0.8314696123025452f, 0.7071067811865476f, 0.5555702330196022f, 0.3826834323650898f, 0.19509032201612825f};
    return (cf){C[m], -S[m]};
}
FD cf twid(int e) { const float f = (float)(e & (FM - 1)) * (1.0f / (float)FM); return (cf){hw_cos_rev(f), -hw_sin_rev(f)}; }
FD int rev14(int p) { return (int)(bitrev32((unsigned)p) >> (32 - LOGM)); }

template <bool CONJ> FD cf mul_c32(cf d, int m) {
    if (m == 0) return d;
    if (m == 8) return CONJ ? (cf){-d.y, d.x} : (cf){d.y, -d.x};
    const cf c = CONJ ? cconj(c32(m)) : c32(m);
    return cmul(d, c);
}
template <int S0, int G, bool INV, int NT, int PRUNE = 0>
FD void fft_pass(LAS cf* X, int tid) {
    constexpr int R = 1 << G;
    constexpr int LOGHG = LOGM - S0 - G, HG = 1 << LOGHG;
    constexpr int NGRP = FM >> G;
    for (int gid = tid; gid < NGRP; gid += NT) {
        const int lo = gid & (HG - 1), hi = gid >> LOGHG, base = (hi << (LOGHG + G)) + lo;
        cf v[R];
#pragma unroll
        for (int q = 0; q < R; ++q) { if (PRUNE == 1 && q >= R / 2) v[q] = (cf){0.f, 0.f}; else v[q] = X[phys(base + q * HG)]; }
        cf Tp[G];
        if (HG > 1) { Tp[0] = twid(lo << S0); if (INV) Tp[0] = cconj(Tp[0]);
#pragma unroll
            for (int st = 1; st < G; ++st) Tp[st] = cmul(Tp[st - 1], Tp[st - 1]); }
#pragma unroll
        for (int sti = 0; sti < G; ++sti) {
            const int st = INV ? (G - 1 - sti) : sti;
            const int dq = R >> (st + 1);
#pragma unroll
            for (int qq = 0; qq < dq; ++qq) {
                const int m = qq * 16 / dq;
                cf W = (cf){1.f, 0.f}, Wp = (cf){0.f, 1.f};
                if (HG > 1) { W = mul_c32<INV>(Tp[st], m); Wp = cperp(W); }
#pragma unroll
                for (int blk = 0; blk < R / (2 * dq); ++blk) {
                    const int q = blk * 2 * dq + qq;
                    const cf a = v[q], b = v[q + dq];
                    if (!INV) { if (PRUNE == 1 && st == 0) { v[q + dq] = (HG > 1) ? cmulp(a, W, Wp) : mul_c32<false>(a, m); }
                        else { v[q] = a + b; cf d = a - b; v[q + dq] = (HG > 1) ? cmulp(d, W, Wp) : mul_c32<false>(d, m); } }
                    else { const cf bb = (HG > 1) ? cmulp(b, W, Wp) : mul_c32<true>(b, m); v[q] = a + bb; if (!(PRUNE == 2 && st == 0)) v[q + dq] = a - bb; }
                }
            }
        }
#pragma unroll
        for (int q = 0; q < R; ++q) { if (!(PRUNE == 2 && q >= R / 2)) X[phys(base + q * HG)] = v[q]; }
    }
}
FD void pair_pos(int q, int& p, int& p2, int& k) { p = 2 * q; k = rev14(p); p2 = rev14((FM - k) & (FM - 1)); }
FD cf wk2(int k) { const float f = (float)k * (0.5f / (float)FM); return (cf){hw_cos_rev(f), -hw_sin_rev(f)}; }
FD void real_unpack(cf Zk, cf Zk2, cf w, cf& Xk, cf& Xmk) {
    const cf Zc = cconj(Zk2);
    const cf E = 0.5f * (Zk + Zc);
    const cf Dm = 0.5f * (Zk - Zc);
    const cf O = (cf){Dm.y, -Dm.x};
    const cf WO = cmul(w, O);
    Xk = E + WO; Xmk = cconj(E - WO);
}
FD void real_pack(cf Yk, cf Ymk, cf w, cf& Zk, cf& Zk2) {
    const cf Yc = cconj(Ymk);
    const cf Ey = 0.5f * (Yk + Yc);
    const cf Dd = 0.5f * (Yk - Yc);
    const cf Oy = cmul(cconj(w), Dd);
    Zk = (cf){Ey.x - Oy.y, Ey.y + Oy.x};
    Zk2 = (cf){Ey.x + Oy.y, -Ey.y + Oy.x};
}
FD int rev10(int v) { return (int)(bitrev32((unsigned)v) >> 22); }
constexpr int rev4c(int v) { return ((v & 1) << 3) | ((v & 2) << 1) | ((v & 4) >> 1) | ((v & 8) >> 3); }
constexpr int blk0_partner(int e) { return rev4c((16 - rev4c(e)) & 15); }
FD void mid_blocks(int tid, int& a, int& gA, int& gB) { a = ((tid & 31) << 4) | (tid >> 5); gA = (tid == 0) ? 0 : rev10(a); gB = (tid == 0) ? 1 : rev10(1024 - a); }
FD int fp_index(int q) { const int g = q >> 3, j = q & 7; int a, set; if ((g & 1) == 0) { a = rev10(g); set = 0; } else { a = (1024 - rev10(g)) & 511; set = 1; }
    const int tid = ((a & 15) << 5) | (a >> 4); return (tid * 2 + set) * 8 + j; }
template <bool INV> FD void bfly16(cf (&v)[16]) {
#pragma unroll
    for (int sti = 0; sti < 4; ++sti) { const int st = INV ? 3 - sti : sti, dq = 16 >> (st + 1);
#pragma unroll
        for (int qq = 0; qq < dq; ++qq) { const int m = qq * 16 / dq;
#pragma unroll
            for (int blk = 0; blk < 16 / (2 * dq); ++blk) { const int q = blk * 2 * dq + qq; const cf a = v[q], b = v[q + dq];
                if (!INV) { v[q] = a + b; v[q + dq] = mul_c32<false>(a - b, m); } else { const cf bb = mul_c32<true>(b, m); v[q] = a + bb; v[q + dq] = a - bb; } } } }
}
FD void pair_apply(cf& own, cf& par, const f32x4 f, const cf wk) {
    cf Xk, Xmk; real_unpack(own, par, wk, Xk, Xmk);
    const cf Yk = cmul(Xk, (cf){f[0], f[1]}), Ymk = cmul(Xmk, (cf){f[2], f[3]});
    cf Zk, Zk2; real_pack(Yk, Ymk, wk, Zk, Zk2); own = Zk; par = Zk2;
}
FD f32x4 unpack_bf16x4(u32x2 r) { return (f32x4){bflo(r.x), bfhi(r.x), bflo(r.y), bfhi(r.y)}; }
FD void fft_mid(LAS cf* X, int tid, const u32x2* Fp) {
    int a, gA, gB; mid_blocks(tid, a, gA, gB);
    LAS cf* pA = X + phys(16 * gA); LAS cf* pB = X + phys(16 * gB);
    cf vA[16], vB[16];
#pragma unroll
    for (int q = 0; q < 16; ++q) { vA[q] = pA[q]; vB[q] = pB[q]; }
    u32x2 fr[16];
#pragma unroll
    for (int i = 0; i < 8; ++i) { const u32x4 t4 = ((const u32x4*)Fp)[tid * 8 + i]; fr[2 * i] = (u32x2){t4.x, t4.y}; fr[2 * i + 1] = (u32x2){t4.z, t4.w}; }
    bfly16<false>(vA); bfly16<false>(vB);
    const cf twA = wk2((tid == 0) ? 0 : a), twB = wk2((tid == 0) ? 512 : 1024 - a);
    if (tid != 0) {
#pragma unroll
        for (int j = 0; j < 8; ++j) { const cf c = c32(rev4c(2 * j));
            pair_apply(vA[2 * j], vB[15 - 2 * j], unpack_bf16x4(fr[j]), cmul(c, twA));
            pair_apply(vB[2 * j], vA[15 - 2 * j], unpack_bf16x4(fr[8 + j]), cmul(c, twB)); }
    } else {
        { const f32x4 f = unpack_bf16x4(fr[0]); const cf Z0 = vA[0], Zh = vA[1];
          const float Y0 = (Z0.x + Z0.y) * f[0], YM = (Z0.x - Z0.y) * f[2];
          vA[0] = (cf){0.5f * (Y0 + YM), 0.5f * (Y0 - YM)}; const cf Yh = cmul(cconj(Zh), (cf){f[1], f[3]}); vA[1] = cconj(Yh); }
#pragma unroll
        for (int j = 1; j < 8; ++j) pair_apply(vA[2 * j], vA[blk0_partner(2 * j)], unpack_bf16x4(fr[j]), cmul(c32(rev4c(2 * j)), twA));
#pragma unroll
        for (int j = 0; j < 8; ++j) pair_apply(vB[2 * j], vB[15 - 2 * j], unpack_bf16x4(fr[8 + j]), cmul(c32(rev4c(2 * j)), twB));
    }
    bfly16<true>(vA); bfly16<true>(vB);
#pragma unroll
    for (int q = 0; q < 16; ++q) { pA[q] = vA[q]; pB[q] = vB[q]; }
}
FD void fft_mid_filter(LAS cf* X, int tid, bf16_t* row, float sc) {
    int a, gA, gB; mid_blocks(tid, a, gA, gB);
    const LAS cf* pA = X + phys(16 * gA); const LAS cf* pB = X + phys(16 * gB);
    cf vA[16], vB[16];
#pragma unroll
    for (int q = 0; q < 16; ++q) { vA[q] = pA[q]; vB[q] = pB[q]; }
    bfly16<false>(vA); bfly16<false>(vB);
    const cf twA = wk2((tid == 0) ? 0 : a), twB = wk2((tid == 0) ? 512 : 1024 - a);
    u32x2 o[16];
#define FMF_PUT_(idx, own, par, wkv) do { cf Xk_, Xmk_; real_unpack(own, par, wkv, Xk_, Xmk_); o[idx].x = cvt_pk_bf16(Xk_.x * sc, Xk_.y * sc); o[idx].y = cvt_pk_bf16(Xmk_.x * sc, Xmk_.y * sc); } while (0)
    if (tid != 0) {
#pragma unroll
        for (int j = 0; j < 8; ++j) { const cf c = c32(rev4c(2 * j));
            FMF_PUT_(j, vA[2 * j], vB[15 - 2 * j], cmul(c, twA));
            FMF_PUT_(8 + j, vB[2 * j], vA[15 - 2 * j], cmul(c, twB)); }
    } else {
        { const cf Z0 = vA[0], Zh = vA[1]; o[0].x = cvt_pk_bf16((Z0.x + Z0.y) * sc, Zh.x * sc); o[0].y = cvt_pk_bf16((Z0.x - Z0.y) * sc, -Zh.y * sc); }
#pragma unroll
        for (int j = 1; j < 8; ++j) FMF_PUT_(j, vA[2 * j], vA[blk0_partner(2 * j)], cmul(c32(rev4c(2 * j)), twA));
#pragma unroll
        for (int j = 0; j < 8; ++j) FMF_PUT_(8 + j, vB[2 * j], vB[15 - 2 * j], cmul(c32(rev4c(2 * j)), twB));
    }
#undef FMF_PUT_
    u32x4* dst = (u32x4*)(row + 64 * tid);
#pragma unroll
    for (int i = 0; i < 8; ++i) dst[i] = (u32x4){o[2 * i].x, o[2 * i].y, o[2 * i + 1].x, o[2 * i + 1].y};
}
FD void fft_forward(LAS cf* X, int tid) {
    fft_pass<0, 5, false, NTHR>(X, tid); __syncthreads();
    fft_pass<5, 5, false, NTHR>(X, tid); __syncthreads();
    fft_pass<10, 4, false, NTHR>(X, tid); __syncthreads();
}
FD void fft_inverse(LAS cf* X, int tid) {
    fft_pass<10, 4, true, NTHR>(X, tid); __syncthreads();
    fft_pass<5, 5, true, NTHR>(X, tid); __syncthreads();
    fft_pass<0, 5, true, NTHR>(X, tid); __syncthreads();
}
}

struct Args {
    const float* in[33]; float* out; unsigned char* ws;
    double invf[32];
};
enum { I_X = 0, I_C, I_CTX, I_CCTX, I_WADA, I_BADA, I_NPRE, I_NPOST, I_WFIN, I_WFOUT, I_HWIN, I_HBIN, I_HWSC, I_HBSC, I_FW1, I_FB1, I_FW2, I_FB2, I_FW3, I_FB3, I_FW4, I_FFREQ, I_HSKIP, I_HWOUT, I_HBOUT,
       I_AWQKV, I_ABQKV, I_ASINK, I_AWO, I_ABO, I_PW, I_PB, I_PSCALE };

__device__ __forceinline__ const CAS char* kargs() { const CAS char* p = (const CAS char*)__builtin_amdgcn_kernarg_segment_ptr(); asm volatile("" : "+s"(p)); return p; }
#define IN(i) (*(const float* const CAS*)(kargs() + 8 * (i)))
#define OUTP (*(float* const CAS*)(kargs() + 8 * 33))
#define WSP (*(unsigned char* const CAS*)(kargs() + 8 * 34))
#define INVF(j) (*(const CAS double*)(kargs() + 8 * 35 + 8 * (j)))
struct Frame {
    LAS unsigned char* lds;
    int tid, lane, wave, G, bid, vcu;
    unsigned char* ws;
};
__device__ __forceinline__ LAS unsigned char* lds_dyn() { extern __shared__ __attribute__((aligned(16))) unsigned char lds_raw[]; return (LAS unsigned char*)lds_raw; }
__device__ __forceinline__ Frame mk_frame() {
    extern __shared__ __attribute__((aligned(16))) unsigned char lds_raw[];
    Frame F; int tid = threadIdx.x; asm volatile("" : "+v"(tid));
    F.lds = (LAS unsigned char*)lds_raw; F.tid = tid; F.lane = tid & 63; F.wave = __builtin_amdgcn_readfirstlane(tid >> 6);
    F.G = gridDim.x; F.bid = blockIdx.x; F.ws = WSP;
    F.vcu = (int)((volatile LAS unsigned*)(F.lds + MISC_OFF))[18]; return F;
}
__device__ __forceinline__ Frame mk_frame_group(int first, int n) { Frame F = mk_frame(); F.bid = (int)blockIdx.x - first; F.G = n; F.vcu = F.bid; return F; }

__device__ __forceinline__ int srccol(int r, int mode) {
    if (mode == 1) { const int pn = r >> 8, w = r & 255; return (w < 128) ? (128 * pn + w) : (DFF + 128 * pn + (w - 128)); }
    if (mode == 2 && r < 2560) { const int e = r & 127, f = e & 63; return (r & ~127) + (e & 64) + (f & 1) * 32 + (f >> 1); }
    return r;
}
struct CvtDesc { const float* W; bf16_t* WT; int K, N, mode, ldw, item; };
__device__ __forceinline__ void cvt_load(const CvtDesc& d, int lane, float (&wv)[32]) {
    const int nblk = d.N / 32, kb = d.item / nblk, nb = d.item % nblk, k0 = 64 * kb, r0 = 32 * nb;
    const int ncol = srccol(r0 + (lane & 31), d.mode);
#pragma unroll
    for (int i = 0; i < 32; ++i) wv[i] = __builtin_nontemporal_load(d.W + (size_t)(k0 + 2 * i + (lane >> 5)) * d.N + ncol);
}
__device__ __forceinline__ void cvt_store(const CvtDesc& d, int lane, const float (&wv)[32], LAS float* scr) {
    const int nblk = d.N / 32, kb = d.item / nblk, nb = d.item % nblk, k0 = 64 * kb, r0 = 32 * nb;
#pragma unroll
    for (int i = 0; i < 32; ++i) scr[(2 * i + (lane >> 5)) * 33 + (lane & 31)] = wv[i];
    LDS_WAIT(); asm volatile("" ::: "memory");
    const int c = lane & 7;
#pragma unroll
    for (int j = 0; j < 4; ++j) { const int n = (lane >> 3) + 8 * j; const LAS float* s = scr + (8 * c) * 33 + n;
        u32x4 o; o.x = cvt_pk_bf16(s[0 * 33], s[1 * 33]); o.y = cvt_pk_bf16(s[2 * 33], s[3 * 33]); o.z = cvt_pk_bf16(s[4 * 33], s[5 * 33]); o.w = cvt_pk_bf16(s[6 * 33], s[7 * 33]);
        *(u32x4*)(d.WT + (size_t)(r0 + n) * d.ldw + k0 + 8 * c) = o; }
    LDS_WAIT(); asm volatile("" ::: "memory");
}
namespace cvt {
constexpr int I_IN = (D / 64) * (2 * DFF / 32), I_OUT = (DFF / 64) * (D / 32), I_HI = (D / 64) * (3 * D / 32), I_SQ = (D / 64) * (D / 32), I_QK = (D / 64) * (QKVD / 32), I_PL = (512 / 64) * (512 / 32);
constexpr int N0 = 3 * I_IN + 3 * I_OUT + I_HI + I_SQ + I_QK;
constexpr int N1 = 5 * I_IN + 5 * I_OUT + I_HI + I_SQ + I_SQ + 4 * I_PL;
}
__device__ __forceinline__ CvtDesc cvt_win(const Frame& F, int j, int r) { return CvtDesc{IN(I_WFIN) + (size_t)j * D * 2 * DFF, (bf16_t*)(F.ws + WS_WIN) + (size_t)j * 2 * DFF * D, D, 2 * DFF, 1, D, r}; }
__device__ __forceinline__ CvtDesc cvt_wout(const Frame& F, int j, int r) { return CvtDesc{IN(I_WFOUT) + (size_t)j * DFF * D, (bf16_t*)(F.ws + WS_WOUT) + (size_t)j * WOUT_STRIDE, DFF, D, 0, DFFP, r}; }
__device__ __forceinline__ CvtDesc cvt_hin(const Frame& F, int j, int r) { return CvtDesc{IN(I_HWIN) + (size_t)j * D * 3 * D, (bf16_t*)(F.ws + WS_WHIN) + (size_t)j * 3 * D * D, D, 3 * D, 0, D, r}; }
__device__ __forceinline__ CvtDesc cvt_hout(const Frame& F, int j, int r) { return CvtDesc{IN(I_HWOUT) + (size_t)j * D * D, (bf16_t*)(F.ws + WS_WHOUT) + (size_t)j * D * D, D, D, 0, D, r}; }
__device__ __forceinline__ CvtDesc cvt_desc(const Frame& F, int list, int it) {
    using namespace cvt;
    if (list == 0) {
        if (it < 3 * I_IN) return cvt_win(F, it / I_IN, it % I_IN); it -= 3 * I_IN;
        if (it < 3 * I_OUT) return cvt_wout(F, it / I_OUT, it % I_OUT); it -= 3 * I_OUT;
        if (it < I_HI) return cvt_hin(F, 0, it); it -= I_HI;
        if (it < I_SQ) return cvt_hout(F, 0, it); it -= I_SQ;
        return CvtDesc{IN(I_AWQKV), (bf16_t*)(F.ws + WS_WQKV), D, QKVD, 2, D, it};
    }
    if (it < 5 * I_IN) return cvt_win(F, 3 + it / I_IN, it % I_IN); it -= 5 * I_IN;
    if (it < 5 * I_OUT) return cvt_wout(F, 3 + it / I_OUT, it % I_OUT); it -= 5 * I_OUT;
    if (it < I_HI) return cvt_hin(F, 1, it); it -= I_HI;
    if (it < I_SQ) return cvt_hout(F, 1, it); it -= I_SQ;
    if (it < I_SQ) return CvtDesc{IN(I_AWO), (bf16_t*)(F.ws + WS_WO), D, D, 0, D, it}; it -= I_SQ;
    { const int j = it / I_PL; return CvtDesc{IN(I_PW) + (size_t)j * 512 * 512, (bf16_t*)(F.ws + WS_WP) + (size_t)j * 512 * 512, 512, 512, 0, 512, it % I_PL}; }
}
__device__ __forceinline__ void p0_convert(const Frame& F, int wsub, int nw, int list) {
    LAS float* scr = (LAS float*)(F.lds + wsub * 8704);
    const int gw = F.bid * nw + wsub, NGW = F.G * nw;
    const int NIT = list == 0 ? cvt::N0 : cvt::N1;
    int it = gw; if (it >= NIT) return;
    float va[32], vb[32];
    CvtDesc da = cvt_desc(F, list, it), db = da;
    cvt_load(da, F.lane, va);
    for (;;) {
        const int itb = it + NGW; const bool hb = itb < NIT;
        if (hb) { db = cvt_desc(F, list, itb); cvt_load(db, F.lane, vb); }
        cvt_store(da, F.lane, va, scr);
        if (!hb) break;
        const int ita = itb + NGW; const bool ha = ita < NIT;
        if (ha) { da = cvt_desc(F, list, ita); cvt_load(da, F.lane, va); }
        cvt_store(db, F.lane, vb, scr);
        if (!ha) break;
        it = ita;
    }
}

__device__ __forceinline__ void p0_mods(const Frame& F) {
    LAS float* sc = (LAS float*)(F.lds + 69632);
    LAS float* red = sc + 4096;
    { const float* cp = IN(I_C); const float* ccp = IN(I_CCTX);
      for (int i = F.tid; i < D; i += NTHR) { sc[i] = silu_f(cp[i]); sc[D + i] = silu_f(ccp[i]); } }
    __syncthreads();
    float* mod = (float*)(F.ws + WS_MOD); float* modc = (float*)(F.ws + WS_MOD + 512 * 1024);
    const float* bada = IN(I_BADA); const float* wada = IN(I_WADA);
    constexpr int NCOL = DEPTH * NMOD * D, CPB = 288, NG = CPB / 32;
    for (int fc0 = F.bid * CPB; fc0 < NCOL; fc0 += F.G * CPB) {
        const int l = fc0 / (NMOD * D), j0 = fc0 % (NMOD * D), cl = F.lane & 31, rp = F.lane >> 5;
        const float* wp = wada + ((size_t)l * D + (size_t)F.wave * 256 + rp) * (NMOD * D) + j0 + cl;
        float a0[NG], a1[NG];
#pragma unroll
        for (int g = 0; g < NG; ++g) { a0[g] = 0.f; a1[g] = 0.f; }
#pragma unroll 4
        for (int kk = 0; kk < 128; ++kk) {
            const float s0 = sc[F.wave * 256 + 2 * kk + rp], s1 = sc[D + F.wave * 256 + 2 * kk + rp];
#pragma unroll
            for (int g = 0; g < NG; ++g) { const float w = __builtin_nontemporal_load(wp + (size_t)(2 * kk) * (NMOD * D) + 32 * g); a0[g] += w * s0; a1[g] += w * s1; } }
#pragma unroll
        for (int g = 0; g < NG; ++g) { a0[g] += __shfl_xor(a0[g], 32); a1[g] += __shfl_xor(a1[g], 32); }
        if (rp == 0) {
#pragma unroll
            for (int g = 0; g < NG; ++g) { red[(F.wave * 2 + 0) * CPB + 32 * g + cl] = a0[g]; red[(F.wave * 2 + 1) * CPB + 32 * g + cl] = a1[g]; } }
        __syncthreads();
        for (int i = F.tid; i < 2 * CPB; i += NTHR) { const int sidx = i / CPB, col = i % CPB; float v = 0.f;
#pragma unroll
            for (int w = 0; w < 8; ++w) v += red[(w * 2 + sidx) * CPB + col];
            const int j = j0 + col; v += bada[l * (NMOD * D) + j];
            if (sidx == 0) mod[l * (NMOD * D) + j] = v; else if (l < 2) modc[l * (NMOD * D) + j] = v; }
        __syncthreads();
    }
}

__device__ __forceinline__ void p0_rope(const Frame& F) {
    f32x2* tab = (f32x2*)(F.ws + WS_ROPE);
    for (int i = F.bid * NTHR + F.tid; i < 256 * 32; i += F.G * NTHR) {
        const int pos = i >> 5, j = i & 31;
        const double rev = (double)pos * INVF(j) * 0.15915494309189535;
        const float fr = (float)(rev - floor(rev));
        tab[i] = (f32x2){__builtin_amdgcn_cosf(fr), __builtin_amdgcn_sinf(fr)};
    }
    float* bqp = (float*)(F.ws + WS_BQP); const float* bq = IN(I_ABQKV); const float* hbo = IN(I_HBOUT);
    for (int i = F.bid * NTHR + F.tid; i < QKVD + 2 * D; i += F.G * NTHR) bqp[i] = (i < QKVD) ? bq[srccol(i, 2)] : 0.25f * hbo[i - QKVD];
}

__device__ __forceinline__ float sin_rad(float x) { const float r = x * 0.15915494309189535f; return __builtin_amdgcn_sinf(r - floorf(r)); }
__device__ __forceinline__ void p0_hidden(const Frame& F, int wsub, int nw, int set_lo, int set_hi) {
    LAS float* hb = (LAS float*)(F.lds + 102400 + F.wave * 2048);
    const int lane = F.lane;
    for (int set = set_lo; set < set_hi; ++set)
    for (int tb = F.bid; tb < ((set == 2) ? CTX : SEQ) / (4 * nw); tb += F.G) {
        const int hj = (set == 1) ? 1 : 0, L = (set == 2) ? CTX : SEQ, t0 = (tb * nw + wsub) * 4;
        const float* w1 = IN(I_FW1) + hj * 33 * 64; const float* b1 = IN(I_FB1) + hj * 64;
        const float* w2 = IN(I_FW2) + hj * 64 * 64; const float* b2 = IN(I_FB2) + hj * 64;
        const float* w3 = IN(I_FW3) + hj * 64 * 64; const float* b3 = IN(I_FB3) + hj * 64;
        const float* fq = IN(I_FFREQ) + hj * 3 * 64;
        if (lane < 33) {
#pragma unroll
            for (int e = 0; e < 4; ++e) { const int t = t0 + e; float z;
                if (lane == 0) z = (float)t / (float)(L - 1);
                else { const int bi = (lane - 1) & 15; const double band = 1e-4 + (double)bi * ((15.0 - 1e-4) / 15.0); const double rev = band * (double)t / (double)L; const float fr = (float)(rev - floor(rev));
                    z = (lane <= 16) ? __builtin_amdgcn_cosf(fr) : -__builtin_amdgcn_sinf(fr); }
                hb[e * 128 + lane] = z; }
        }
        LDS_WAIT(); __builtin_amdgcn_wave_barrier();
        float acc[4], f[4];
#pragma unroll
        for (int e = 0; e < 4; ++e) acc[e] = b1[lane];
#pragma unroll 11
        for (int i = 0; i < 33; ++i) { const float w = w1[i * 64 + lane];
#pragma unroll
            for (int e = 0; e < 4; ++e) acc[e] += hb[e * 128 + i] * w; }
#pragma unroll
        for (int e = 0; e < 4; ++e) f[e] = sin_rad(fq[lane] * acc[e]);
        LDS_WAIT(); __builtin_amdgcn_wave_barrier();
#pragma unroll
        for (int e = 0; e < 4; ++e) hb[e * 128 + 64 + lane] = f[e];
        LDS_WAIT(); __builtin_amdgcn_wave_barrier();
#pragma unroll
        for (int e = 0; e < 4; ++e) acc[e] = b2[lane];
#pragma unroll 16
        for (int i = 0; i < 64; ++i) { const float w = w2[i * 64 + lane];
#pragma unroll
            for (int e = 0; e < 4; ++e) acc[e] += hb[e * 128 + 64 + i] * w; }
#pragma unroll
        for (int e = 0; e < 4; ++e) f[e] = sin_rad(fq[64 + lane] * acc[e]);
        LDS_WAIT(); __builtin_amdgcn_wave_barrier();
#pragma unroll
        for (int e = 0; e < 4; ++e) hb[e * 128 + lane] = f[e];
        LDS_WAIT(); __builtin_amdgcn_wave_barrier();
#pragma unroll
        for (int e = 0; e < 4; ++e) acc[e] = b3[lane];
#pragma unroll 16
        for (int i = 0; i < 64; ++i) { const float w = w3[i * 64 + lane];
#pragma unroll
            for (int e = 0; e < 4; ++e) acc[e] += hb[e * 128 + i] * w; }
#pragma unroll
        for (int e = 0; e < 4; ++e) ((float*)(F.ws + WS_HID))[((size_t)set * SEQ + t0 + e) * 64 + lane] = sin_rad(fq[128 + lane] * acc[e]);
        LDS_WAIT(); __builtin_amdgcn_wave_barrier();
    }
}

typedef float f32x16 __attribute__((ext_vector_type(16)));
__device__ __forceinline__ void split_hilo(const float (&v)[8], bf16x8& hi, bf16x8& lo) {
    u32x4 h, l;
#pragma unroll
    for (int e = 0; e < 4; ++e) { const unsigned hw = cvt_pk_bf16(v[2 * e], v[2 * e + 1]); h[e] = hw; l[e] = cvt_pk_bf16(v[2 * e] - bflo(hw), v[2 * e + 1] - bfhi(hw)); }
    hi = __builtin_bit_cast(bf16x8, h); lo = __builtin_bit_cast(bf16x8, l);
}
typedef float f32x16v __attribute__((ext_vector_type(16)));
template <bool CTXSET> __device__ __forceinline__ void p0_filter_td(const Frame& F, int wsub, int nw, int it_lo, int it_hi) {
    const int hf = F.lane >> 5, li = F.lane & 31;
    const float* w4base = IN(I_FW4);
    for (int it = it_lo + F.bid; it < it_hi; it += F.G) {
        const int dir = it & 1, i2 = it >> 1;
        int set, cg, tq, ntile; if (i2 < 512) { set = i2 >> 8; cg = (i2 & 255) >> 2; tq = i2 & 3; ntile = 128; } else { set = 2; cg = i2 - 512; tq = 0; ntile = 8; }
        const int hj = (set == 1) ? 1 : 0, L = (set == 2) ? CTX : SEQ, L2 = 2 * L, c0 = cg * 32;
        const float* w4 = w4base + (size_t)hj * 64 * 2 * D + dir * D;
        bf16x8 Ah[4], Al[4];
#pragma unroll
        for (int ks = 0; ks < 4; ++ks) { float v[8];
#pragma unroll
            for (int jj = 0; jj < 8; ++jj) v[jj] = w4[(16 * ks + 8 * hf + jj) * (2 * D) + c0 + li];
            split_hilo(v, Ah[ks], Al[ks]); }
        float* outc = (float*)(F.ws + WS_FILTC); bf16_t* outb = (bf16_t*)(F.ws + WS_FILT + (size_t)(set & 1) * 128 * MiB);
        const float* hid = (const float*)(F.ws + WS_HID) + (size_t)set * SEQ * 64;
        f32x4 Bv[8], Bn[8];
        int tile = tq * 128 + wsub; const int tend = tq * 128 + ntile;
        if (tile < tend) { const int t = tile * 32 + li;
#pragma unroll
            for (int ks = 0; ks < 4; ++ks) { Bv[2 * ks] = *(const f32x4*)(hid + (size_t)t * 64 + 16 * ks + 8 * hf); Bv[2 * ks + 1] = *(const f32x4*)(hid + (size_t)t * 64 + 16 * ks + 8 * hf + 4); } }
        for (; tile < tend; tile += nw) {
            const int t = tile * 32 + li;
            const bool hn = tile + nw < tend;
            if (hn) { const int tn2 = (tile + nw) * 32 + li;
#pragma unroll
                for (int ks = 0; ks < 4; ++ks) { Bn[2 * ks] = *(const f32x4*)(hid + (size_t)tn2 * 64 + 16 * ks + 8 * hf); Bn[2 * ks + 1] = *(const f32x4*)(hid + (size_t)tn2 * 64 + 16 * ks + 8 * hf + 4); } }
            f32x16v acc;
#pragma unroll
            for (int r = 0; r < 16; ++r) acc[r] = 0.f;
#pragma unroll
            for (int ks = 0; ks < 4; ++ks) {
                const float v[8] = {Bv[2 * ks][0], Bv[2 * ks][1], Bv[2 * ks][2], Bv[2 * ks][3], Bv[2 * ks + 1][0], Bv[2 * ks + 1][1], Bv[2 * ks + 1][2], Bv[2 * ks + 1][3]};
                bf16x8 bh, bl; split_hilo(v, bh, bl);
                acc = __builtin_amdgcn_mfma_f32_32x32x16_bf16(Al[ks], bh, acc, 0, 0, 0);
                acc = __builtin_amdgcn_mfma_f32_32x32x16_bf16(Ah[ks], bl, acc, 0, 0, 0);
                acc = __builtin_amdgcn_mfma_f32_32x32x16_bf16(Ah[ks], bh, acc, 0, 0, 0);
            }
            const float tn = (float)t / (float)(L - 1);
#pragma unroll
            for (int r = 0; r < 16; ++r) { const int c = c0 + (r & 3) + 8 * (r >> 2) + 4 * hf;
                const float lin = -3.0701134573253943f + (float)c * ((-15.350567286626972f + 3.0701134573253943f) / (float)(D - 1));
                const float dec = __builtin_amdgcn_exp2f(-1.4426950408889634f * tn * fabsf(lin));
                const float val = acc[r] * dec;
                if (CTXSET) { float* orow = outc + (size_t)c * L2;
                    if (dir == 0) orow[t] = val; else { if (t == 0) orow[L] = 0.f; else orow[L2 - t] = val; } }
                else { bf16_t* orow = outb + (size_t)c * L2;
                    if (dir == 0) orow[t] = f2bf(val); else { if (t == 0) orow[L] = (bf16_t)0; else orow[L2 - t] = f2bf(val); } } }
            if (hn) {
#pragma unroll
                for (int j = 0; j < 8; ++j) Bv[j] = Bn[j]; }
        }
    }
}

__device__ __forceinline__ void p0_filter_fft(const Frame& F) {
    using namespace fftc;
    LAS cf* X = (LAS cf*)F.lds;
    for (int it = F.bid; it < 2 * D; it += F.G) {
        int tid = F.tid; asm volatile("" : "+v"(tid));
        bf16_t* row = (bf16_t*)(F.ws + WS_FILT + (size_t)(it / D) * 128 * MiB) + (size_t)(it % D) * (2 * SEQ);
#pragma unroll
        for (int i = tid; i < FM / 4; i += NTHR) { const u32x4 v = *(const u32x4*)(row + 8 * i); LAS cf* d = X + phys(4 * i);
            d[0] = (cf){bflo(v[0]), bfhi(v[0])}; d[1] = (cf){bflo(v[1]), bfhi(v[1])}; d[2] = (cf){bflo(v[2]), bfhi(v[2])}; d[3] = (cf){bflo(v[3]), bfhi(v[3])}; }
        __syncthreads();
        unsigned pfn = 0u;
        if (it + F.G < 2 * D) { const int nx = it + F.G; pfn = *(const unsigned*)((const bf16_t*)(F.ws + WS_FILT + (size_t)(nx / D) * 128 * MiB) + (size_t)(nx % D) * (2 * SEQ) + 64 * tid); }
        fft_pass<0, 5, false, NTHR>(X, tid); __syncthreads();
        fft_pass<5, 5, false, NTHR>(X, tid); __syncthreads();
        asm volatile("" :: "v"(pfn));
        fft_mid_filter(X, tid, row, 1.0f / (float)FM);
        __syncthreads();
    }
}

__device__ __forceinline__ void thin_phase(const Frame& F, int ph, bool ctx) {
    LAS float* cA = (LAS float*)F.lds;
    LAS float* cB = cA + D; LAS float* cC = cA + 2 * D;
    const float* mod = ctx ? (const float*)(F.ws + WS_MOD + 512 * 1024) : (const float*)(F.ws + WS_MOD);
    const int l = ph / 3, k = ph % 3, pl = (ph - 1) / 3, pk = (ph - 1) % 3;
    const bool has_prev = ph >= 1, has_next = ph < 12;
    const float* npost = IN(I_NPOST); const float* npre = IN(I_NPRE); const float* xin = ctx ? IN(I_CTX) : IN(I_X); float* outp = OUTP;
    for (int i = F.tid; i < D; i += NTHR) {
        if (has_prev) { const float wgt = (pk == 1) ? 1.0f : 0.5f, gp = npost[(pl * 3 + pk) * D + i]; cA[i] = wgt * gp * mod[pl * (NMOD * D) + (3 * pk + 2) * D + i]; }
        if (has_next) { const float g = npre[(l * 3 + k) * D + i]; cB[i] = g * (1.0f + mod[l * (NMOD * D) + (3 * k + 1) * D + i]); cC[i] = mod[l * (NMOD * D) + (3 * k) * D + i]; }
    }
    __syncthreads();
    const int row0 = ctx ? SEQ : 0, nrows = ctx ? CTX : SEQ;
    _Float16* H = (_Float16*)(F.ws + WS_H); const bf16_t* Y = (const bf16_t*)(F.ws + WS_Y); bf16_t* U = (bf16_t*)(F.ws + WS_U); const bf16_t* PP = (const bf16_t*)(F.ws + WS_P);
    const int nsplit = (pk != 1) ? 11 : 4;
    const bool xl = !ctx && ((volatile LAS unsigned*)(F.lds + MISC_OFF))[19] != 0u && F.G == 256;
    const int rstart = xl ? (F.vcu & 7) * 2048 + (F.vcu >> 3) * NWAVES + F.wave : F.bid * NWAVES + F.wave;
    const int rstep = xl ? 256 : F.G * NWAVES, rend = xl ? (F.vcu & 7) * 2048 + 2048 : nrows;
    f16x4 hN[8]; u32x2 yN[8];
    if (ph != 0 && rstart < rend) {
#pragma unroll
        for (int j = 0; j < 8; ++j) { hN[j] = __builtin_nontemporal_load((const f16x4*)(H + (size_t)(row0 + rstart) * D + 4 * (F.lane + 64 * j))); yN[j] = !ctx ? __builtin_nontemporal_load((const u32x2*)(Y + (size_t)(row0 + rstart) * D + 4 * (F.lane + 64 * j))) : (u32x2){0u, 0u}; } }
    for (int r = rstart; r < rend; r += rstep) {
        const int row = row0 + r;
        f32x4 h[8]; u32x2 yc[8];
        if (ph == 0) {
#pragma unroll
            for (int j = 0; j < 8; ++j) { h[j] = __builtin_nontemporal_load((const f32x4*)(xin + (size_t)r * D + 4 * (F.lane + 64 * j))); yc[j] = (u32x2){0u, 0u}; }
        } else {
#pragma unroll
            for (int j = 0; j < 8; ++j) { h[j] = __builtin_convertvector(hN[j], f32x4); yc[j] = yN[j]; }
            if (r + rstep < rend) { const int rn = row0 + r + rstep;
#pragma unroll
                for (int j = 0; j < 8; ++j) { hN[j] = __builtin_nontemporal_load((const f16x4*)(H + (size_t)rn * D + 4 * (F.lane + 64 * j))); yN[j] = !ctx ? __builtin_nontemporal_load((const u32x2*)(Y + (size_t)rn * D + 4 * (F.lane + 64 * j))) : (u32x2){0u, 0u}; } }
        }
        if (has_prev) {
            f32x4 y[8]; float ss = 0.f;
#pragma unroll
            for (int j = 0; j < 8; ++j) {
                if (!ctx) { const u32x2 yr = yc[j]; y[j] = (f32x4){bflo(yr.x), bfhi(yr.x), bflo(yr.y), bfhi(yr.y)}; }
                else { u32x2 yr[11];
#pragma unroll
                    for (int sp = 0; sp < 11; ++sp) yr[sp] = (sp < nsplit) ? *(const u32x2*)(PP + ((size_t)sp * 256 + r) * D + 4 * (F.lane + 64 * j)) : (u32x2){0u, 0u};
                    y[j] = (f32x4){0.f, 0.f, 0.f, 0.f};
#pragma unroll
                    for (int sp = 0; sp < 11; ++sp) y[j] += (f32x4){bflo(yr[sp].x), bfhi(yr[sp].x), bflo(yr[sp].y), bfhi(yr[sp].y)}; }
                if (ctx) asm volatile("" ::: "memory");
                ss += (y[j][0] * y[j][0] + y[j][1] * y[j][1]) + (y[j][2] * y[j][2] + y[j][3] * y[j][3]); }
            const float rstd = 1.0f / sqrtf(wave_sum(ss) * (1.0f / D) + NORM_EPS);
#pragma unroll
            for (int j = 0; j < 8; ++j) { const f32x4 cv = *(const LAS f32x4*)(cA + 4 * (F.lane + 64 * j)); h[j] += cv * (y[j] * rstd); }
        }
        if (!has_next) {
#pragma unroll
            for (int j = 0; j < 8; ++j) __builtin_nontemporal_store(h[j], (f32x4*)(outp + (size_t)row * D + 4 * (F.lane + 64 * j)));
            continue;
        }
        float ss2 = 0.f;
#pragma unroll
        for (int j = 0; j < 8; ++j) { __builtin_nontemporal_store(__builtin_convertvector(h[j], f16x4), (f16x4*)(H + (size_t)row * D + 4 * (F.lane + 64 * j))); ss2 += (h[j][0] * h[j][0] + h[j][1] * h[j][1]) + (h[j][2] * h[j][2] + h[j][3] * h[j][3]); }
        const float rstd2 = 1.0f / sqrtf(wave_sum(ss2) * (1.0f / D) + NORM_EPS);
#pragma unroll
        for (int j = 0; j < 8; ++j) { const f32x4 bv = *(const LAS f32x4*)(cB + 4 * (F.lane + 64 * j)), cv = *(const LAS f32x4*)(cC + 4 * (F.lane + 64 * j));
            const f32x4 u = (h[j] * rstd2) * bv + cv; u32x2 w; w.x = cvt_pk_bf16(u[0], u[1]); w.y = cvt_pk_bf16(u[2], u[3]);
            *(u32x2*)(U + (size_t)row * D + 4 * (F.lane + 64 * j)) = w; }
    }
    __syncthreads();
}

__device__ __forceinline__ void sc8(const bf16_t* row, int t0, int len, float w0, float w1, float w2, float b, float (&o)[8]) {
    const u32x4 raw = *(const u32x4*)(row + t0);
    float x[10];
    x[0] = (t0 > 0) ? bf2f(row[t0 - 1]) : 0.f; x[9] = (t0 + 8 < len) ? bf2f(row[t0 + 8]) : 0.f;
#pragma unroll
    for (int e = 0; e < 4; ++e) { x[1 + 2 * e] = bflo(raw[e]); x[2 + 2 * e] = bfhi(raw[e]); }
#pragma unroll
    for (int e = 0; e < 8; ++e) o[e] = x[e] * w0 + x[e + 1] * w1 + x[e + 2] * w2 + b;
}
__device__ __forceinline__ void sc_pair(const bf16_t* row, int t0, int len, float w0, float w1, float w2, float b, float& o0, float& o1) {
    const unsigned pr = *(const unsigned*)(row + t0); const float x0 = bflo(pr), x1 = bfhi(pr);
    const float xm = (t0 > 0) ? bf2f(row[t0 - 1]) : 0.f, xp = (t0 + 2 < len) ? bf2f(row[t0 + 2]) : 0.f;
    o0 = xm * w0 + x0 * w1 + x1 * w2 + b; o1 = x0 * w0 + x1 * w1 + xp * w2 + b;
}
#if defined(DIAG_MASK)
__device__ __forceinline__ void diag_stamp(int cls) {
#ifndef DIAG_BLK
#define DIAG_BLK 0
#endif
    if (blockIdx.x == DIAG_BLK && threadIdx.x == 0) {
        extern __shared__ __attribute__((aligned(16))) unsigned char lds_raw[];
        volatile LAS unsigned long long* ta = (volatile LAS unsigned long long*)((LAS unsigned char*)lds_raw + MISC_OFF + 256);
        const unsigned long long t = __builtin_amdgcn_s_memrealtime();
        if (ta[0] != 0ull) ta[1 + cls] += t - ta[0];
        ta[0] = t;
    }
}
#define STAMP(cls) diag_stamp(cls)
#else
#define STAMP(cls) do { } while (0)
#endif
#if defined(DIAG_MASK) && defined(DIAG_CONV)
#define CSTAMP(cls) diag_stamp(cls)
#else
#define CSTAMP(cls) do { } while (0)
#endif
struct Taps { float a0, a1, a2, ab, b0, b1, b2, bb, v0, v1, v2, vb, skip; };
__device__ __forceinline__ Taps load_taps(const float* wsc, const float* bsc, const float* skp, int hj, int c) {
    Taps t;
    t.a0 = wsc[c]; t.a1 = wsc[3 * D + c]; t.a2 = wsc[6 * D + c]; t.ab = bsc[c];
    t.b0 = wsc[D + c]; t.b1 = wsc[3 * D + D + c]; t.b2 = wsc[6 * D + D + c]; t.bb = bsc[D + c];
    t.v0 = wsc[2 * D + c]; t.v1 = wsc[3 * D + 2 * D + c]; t.v2 = wsc[6 * D + 2 * D + c]; t.vb = bsc[2 * D + c];
    t.skip = skp[hj * D + c];
    return t;
}
__device__ __forceinline__ void hyena_conv_phase(const Frame& F, int hj, int set) {
    using namespace fftc;
    LAS cf* X = (LAS cf*)F.lds;
    for (int c = F.bid; c < D; c += F.G) {
        int tid = F.tid; asm volatile("" : "+v"(tid));
        CSTAMP(21);
        {
            const bf16_t* ZT = (const bf16_t*)(F.ws + WS_ZT);
            const bf16_t* r1 = ZT + (size_t)(D + c) * MT; const bf16_t* r2 = ZT + (size_t)(2 * D + c) * MT;
            const Taps T = load_taps(IN(I_HWSC) + (size_t)hj * 3 * (3 * D), IN(I_HBSC) + (size_t)hj * (3 * D), IN(I_HSKIP), hj, c);
#pragma unroll
            for (int i = 0; i < 4; ++i) {
                const int ch = i * NTHR + tid, t0 = 8 * ch, n0 = 4 * ch;
                float p[8], q[8]; sc8(r1, t0, SEQ, T.b0, T.b1, T.b2, T.bb, p); sc8(r2, t0, SEQ, T.v0, T.v1, T.v2, T.vb, q);
                LAS cf* dst = X + phys(n0);
                dst[0] = (cf){p[0] * q[0], p[1] * q[1]}; dst[1] = (cf){p[2] * q[2], p[3] * q[3]}; dst[2] = (cf){p[4] * q[4], p[5] * q[5]}; dst[3] = (cf){p[6] * q[6], p[7] * q[7]};
            }
        }
        __syncthreads(); CSTAMP(16);
        const bf16_t* fprow = (const bf16_t*)(F.ws + WS_FILT + (size_t)set * 128 * MiB) + (size_t)c * (2 * SEQ);
        const unsigned pf0 = *(const unsigned*)(fprow + 64 * tid), pf1 = 0u;
        unsigned pz0 = 0u, pz1 = 0u;
        if (c + F.G < D) { const bf16_t* zn = (const bf16_t*)(F.ws + WS_ZT) + (size_t)(c + F.G) * MT;
            pz0 = *(const unsigned*)(zn + (size_t)((tid >> 8) * D) * MT + 64 * (tid & 255));
            if (tid < 256) pz1 = *(const unsigned*)(zn + (size_t)(2 * D) * MT + 64 * tid); }
        fft_pass<0, 5, false, NTHR, 1>(X, tid); __syncthreads();
        fft_pass<5, 5, false, NTHR>(X, tid); __syncthreads(); CSTAMP(17);
        asm volatile("" :: "v"(pf0), "v"(pf1), "v"(pz0), "v"(pz1));
        fft_mid(X, tid, (const u32x2*)((const bf16_t*)(F.ws + WS_FILT + (size_t)set * 128 * MiB) + (size_t)c * (2 * SEQ)));
        __syncthreads(); CSTAMP(18);
        fft_pass<5, 5, true, NTHR>(X, tid); __syncthreads();
        fft_pass<0, 5, true, NTHR, 2>(X, tid); __syncthreads(); CSTAMP(19);
        {
            const bf16_t* ZT = (const bf16_t*)(F.ws + WS_ZT); bf16_t* GT = (bf16_t*)(F.ws + WS_GT);
            const bf16_t* r0 = ZT + (size_t)c * MT; const bf16_t* r1 = ZT + (size_t)(D + c) * MT; const bf16_t* r2 = ZT + (size_t)(2 * D + c) * MT;
            const Taps T = load_taps(IN(I_HWSC) + (size_t)hj * 3 * (3 * D), IN(I_HBSC) + (size_t)hj * (3 * D), IN(I_HSKIP), hj, c);
#pragma unroll 2
            for (int i = 0; i < 4; ++i) {
                const int ch = i * NTHR + tid, t0 = 8 * ch, n0 = 4 * ch;
                const LAS cf* src = X + phys(n0);
                const cf s0 = src[0], s1 = src[1], s2 = src[2], s3 = src[3];
                const f32x4 y0 = (f32x4){s0.x, s0.y, s1.x, s1.y}, y1 = (f32x4){s2.x, s2.y, s3.x, s3.y};
                float x0c[8], p[8], q[8]; sc8(r0, t0, SEQ, T.a0, T.a1, T.a2, T.ab, x0c); sc8(r1, t0, SEQ, T.b0, T.b1, T.b2, T.bb, p); sc8(r2, t0, SEQ, T.v0, T.v1, T.v2, T.vb, q);
                u32x4 o;
                o.x = cvt_pk_bf16(x0c[0] * (y0[0] + p[0] * q[0] * T.skip), x0c[1] * (y0[1] + p[1] * q[1] * T.skip));
                o.y = cvt_pk_bf16(x0c[2] * (y0[2] + p[2] * q[2] * T.skip), x0c[3] * (y0[3] + p[3] * q[3] * T.skip));
                o.z = cvt_pk_bf16(x0c[4] * (y1[0] + p[4] * q[4] * T.skip), x0c[5] * (y1[1] + p[5] * q[5] * T.skip));
                o.w = cvt_pk_bf16(x0c[6] * (y1[2] + p[6] * q[6] * T.skip), x0c[7] * (y1[3] + p[7] * q[7] * T.skip));
                *(u32x4*)(GT + (size_t)c * MT + t0) = o;
            }
        }
        __syncthreads(); CSTAMP(20);
    }
}
__device__ __forceinline__ void hyena_conv_ctx(const Frame& F, int hj) {
    const bf16_t* ZT = (const bf16_t*)(F.ws + WS_ZT); bf16_t* GT = (bf16_t*)(F.ws + WS_GT);
    const int qd = F.tid >> 7, t = F.tid & 127;
    LAS float* wb = (LAS float*)F.lds + qd * (3 * CTX); LAS float* fb = wb + CTX;
    for (int c4 = F.bid; c4 < D / 4; c4 += F.G) {
        const int c = 4 * c4 + qd;
        const bf16_t* r0 = ZT + (size_t)c * MT + SEQ; const bf16_t* r1 = ZT + (size_t)(D + c) * MT + SEQ; const bf16_t* r2 = ZT + (size_t)(2 * D + c) * MT + SEQ;
        const Taps T = load_taps(IN(I_HWSC) + (size_t)hj * 3 * (3 * D), IN(I_HBSC) + (size_t)hj * (3 * D), IN(I_HSKIP), hj, c);
        const float* fc = (const float*)(F.ws + WS_FILTC) + (size_t)c * (2 * CTX);
        float wv[2], x0c[2];
#pragma unroll
        for (int o = 0; o < 2; ++o) { const int to = t + 128 * o, te = to & ~1; float p0, p1, q0, q1, xa, xb;
            sc_pair(r1, te, CTX, T.b0, T.b1, T.b2, T.bb, p0, p1); sc_pair(r2, te, CTX, T.v0, T.v1, T.v2, T.vb, q0, q1); sc_pair(r0, te, CTX, T.a0, T.a1, T.a2, T.ab, xa, xb);
            wv[o] = (to & 1) ? p1 * q1 : p0 * q0; x0c[o] = (to & 1) ? xb : xa; wb[to] = wv[o]; }
#pragma unroll
        for (int o = 0; o < 4; ++o) fb[t + 128 * o] = fc[t + 128 * o];
        __syncthreads();
        float a0[8], a1[8];
#pragma unroll
        for (int e = 0; e < 8; ++e) { a0[e] = 0.f; a1[e] = 0.f; }
        for (int s2 = 0; s2 < CTX; s2 += 8) {
#pragma unroll
            for (int e = 0; e < 8; ++e) { const float w = wb[s2 + e]; a0[e] += fb[(t - s2 - e) & (2 * CTX - 1)] * w; a1[e] += fb[(t + 128 - s2 - e) & (2 * CTX - 1)] * w; } }
        const float acc0 = ((a0[0] + a0[1]) + (a0[2] + a0[3])) + ((a0[4] + a0[5]) + (a0[6] + a0[7]));
        const float acc1 = ((a1[0] + a1[1]) + (a1[2] + a1[3])) + ((a1[4] + a1[5]) + (a1[6] + a1[7]));
        GT[(size_t)c * MT + SEQ + t] = f2bf(x0c[0] * (acc0 + wv[0] * T.skip));
        GT[(size_t)c * MT + SEQ + t + 128] = f2bf(x0c[1] * (acc1 + wv[1] * T.skip));
        __syncthreads();
    }
}

__device__ __forceinline__ void transpose_phase(const Frame& F, int trow0, int nrows) {
    LAS bf16_t* tile = (LAS bf16_t*)(F.lds + F.wave * 8704);
    const bf16_t* GT = (const bf16_t*)(F.ws + WS_GT); bf16_t* U = (bf16_t*)(F.ws + WS_U);
    const int ntt = nrows / 64, ntiles = (D / 64) * ntt;
    const int rl = F.lane >> 4, cc = (F.lane & 15) * 4, stride = F.G * NWAVES;
    int it = F.bid * NWAVES + F.wave;
    u32x2 v[16];
    if (it < ntiles) { const int c0 = (it / ntt) * 64, t0 = trow0 + (it % ntt) * 64;
#pragma unroll
        for (int i = 0; i < 16; ++i) v[i] = __builtin_nontemporal_load((const u32x2*)(GT + (size_t)(c0 + 4 * i + rl) * MT + t0 + cc)); }
    for (; it < ntiles; it += stride) {
        const int c0 = (it / ntt) * 64, t0 = trow0 + (it % ntt) * 64;
#pragma unroll
        for (int i = 0; i < 16; ++i) { const int r = 4 * i + rl;
            tile[r * 66 + cc] = (bf16_t)(v[i].x & 0xffff); tile[r * 66 + cc + 1] = (bf16_t)(v[i].x >> 16); tile[r * 66 + cc + 2] = (bf16_t)(v[i].y & 0xffff); tile[r * 66 + cc + 3] = (bf16_t)(v[i].y >> 16); }
        LDS_WAIT(); __builtin_amdgcn_wave_barrier();
        const int nx = it + stride;
        if (nx < ntiles) { const int c1 = (nx / ntt) * 64, t1 = trow0 + (nx % ntt) * 64;
#pragma unroll
            for (int i = 0; i < 16; ++i) v[i] = __builtin_nontemporal_load((const u32x2*)(GT + (size_t)(c1 + 4 * i + rl) * MT + t1 + cc)); }
#pragma unroll 4
        for (int i = 0; i < 16; ++i) { const int t = 4 * i + rl;
            const unsigned e0 = tile[(cc + 0) * 66 + t], e1 = tile[(cc + 1) * 66 + t], e2 = tile[(cc + 2) * 66 + t], e3 = tile[(cc + 3) * 66 + t];
            u32x2 w; w.x = e0 | (e1 << 16); w.y = e2 | (e3 << 16);
            *(u32x2*)(U + (size_t)(t0 + t) * D + c0 + cc) = w; }
        LDS_WAIT(); __builtin_amdgcn_wave_barrier();
    }
}

typedef short s16x4 __attribute__((ext_vector_type(4)));
__device__ __forceinline__ void attn_phase(const Frame& F) {
    constexpr int KP = 288;
    LAS unsigned char* Ks = F.lds; LAS unsigned char* Vs = F.lds + 64 * KP;
    const bf16_t* QKV = (const bf16_t*)(F.ws + WS_ZT); bf16_t* O = (bf16_t*)(F.ws + WS_U); const bf16_t* KVC = (const bf16_t*)(F.ws + WS_KVC);
    const int fr = F.lane & 15, fq = F.lane >> 4; const float* sinkp = IN(I_ASINK);
    for (int unit = F.bid; unit < (SEQ / 128) * 16; unit += F.G) {
        const int qb = unit >> 4, h = unit & 15, kvh = h >> 2, q0 = qb * 128 + 16 * F.wave;
        bf16x8 Qf[4];
#pragma unroll
        for (int ks = 0; ks < 4; ++ks) Qf[ks] = *(const bf16x8*)(QKV + (size_t)(q0 + fr) * QKVD + h * 128 + 32 * ks + 8 * fq);
        float m = sinkp[h] * 1.4426950408889634f;
        float lpart = (fq == 0) ? 1.0f : 0.0f;
        f32x4 Oacc[8];
#pragma unroll
        for (int dt = 0; dt < 8; ++dt) Oacc[dt] = (f32x4){0.f, 0.f, 0.f, 0.f};
        const int ti_first = (qb == 0) ? 2 : 0, nloc = ((qb == SEQ / 128 - 1) ? 4 : 6) - ti_first, nslot = nloc + 4;
        const int lr = F.tid >> 4, lch = F.tid & 15;
        u32x4 pk[2], pv[2];
        { const int krow0 = (qb - 1) * 128 + 64 * ti_first;
#pragma unroll
          for (int hh = 0; hh < 2; ++hh) { const bf16_t* src = QKV + (size_t)(krow0 + lr + 32 * hh) * QKVD + kvh * 128 + lch * 8; pk[hh] = *(const u32x4*)(src + 2048); pv[hh] = *(const u32x4*)(src + 2560); } }
        for (int sl = 0; sl < nslot; ++sl) {
            const bool is_ctx = sl >= nloc;
            const int krow0 = is_ctx ? SEQ + 64 * (sl - nloc) : (qb - 1) * 128 + 64 * (ti_first + sl);
            __syncthreads();
#pragma unroll
            for (int hh = 0; hh < 2; ++hh) { *(LAS u32x4*)(Ks + (lr + 32 * hh) * KP + lch * 16) = pk[hh]; *(LAS u32x4*)(Vs + (lr + 32 * hh) * KP + lch * 16) = pv[hh]; }
            __syncthreads();
            if (sl + 1 < nslot) { const int s2 = sl + 1;
                if (s2 >= nloc) {
#pragma unroll
                    for (int hh = 0; hh < 2; ++hh) { const bf16_t* src = KVC + (size_t)(64 * (s2 - nloc) + lr + 32 * hh) * 1024 + kvh * 128 + lch * 8; pk[hh] = *(const u32x4*)src; pv[hh] = *(const u32x4*)(src + 512); }
                } else { const int kn = (qb - 1) * 128 + 64 * (ti_first + s2);
#pragma unroll
                    for (int hh = 0; hh < 2; ++hh) { const bf16_t* src = QKV + (size_t)(kn + lr + 32 * hh) * QKVD + kvh * 128 + lch * 8; pk[hh] = *(const u32x4*)(src + 2048); pv[hh] = *(const u32x4*)(src + 2560); } } }
            const bool active = is_ctx || !(krow0 + 63 < q0 - 128 || krow0 > q0 + 15 + 128);
            if (active) {
                f32x4 st[4];
#pragma unroll
                for (int kt = 0; kt < 4; ++kt) { st[kt] = (f32x4){0.f, 0.f, 0.f, 0.f};
#pragma unroll
                    for (int ks = 0; ks < 4; ++ks) { const bf16x8 kf = *(const LAS bf16x8*)(Ks + (16 * kt + fr) * KP + (32 * ks + 8 * fq) * 2);
                        st[kt] = __builtin_amdgcn_mfma_f32_16x16x32_bf16(kf, Qf[ks], st[kt], 0, 0, 0); } }
                const float cs = 0.08838834764831845f * 1.4426950408889634f;
                float tmax = -INFINITY;
#pragma unroll
                for (int kt = 0; kt < 4; ++kt)
#pragma unroll
                    for (int r = 0; r < 4; ++r) { float v = st[kt][r] * cs;
                        if (!is_ctx) { const int dk = (krow0 + 16 * kt + 4 * fq + r) - (q0 + fr); if (dk > 128 || dk < -128) v = -INFINITY; }
                        st[kt][r] = v; tmax = fmaxf(tmax, v); }
                tmax = fmaxf(tmax, __shfl_xor(tmax, 16)); tmax = fmaxf(tmax, __shfl_xor(tmax, 32));
                const float mn = fmaxf(m, tmax), alpha = __builtin_amdgcn_exp2f(m - mn); m = mn;
                lpart *= alpha;
#pragma unroll
                for (int dt = 0; dt < 8; ++dt) Oacc[dt] *= alpha;
                bf16x8 pf[2];
#pragma unroll
                for (int kk = 0; kk < 2; ++kk) { float p[8];
#pragma unroll
                    for (int j = 0; j < 8; ++j) { p[j] = __builtin_amdgcn_exp2f(st[2 * kk + (j >> 2)][j & 3] - m); lpart += p[j]; }
                    u32x4 w; w.x = cvt_pk_bf16(p[0], p[1]); w.y = cvt_pk_bf16(p[2], p[3]); w.z = cvt_pk_bf16(p[4], p[5]); w.w = cvt_pk_bf16(p[6], p[7]);
                    pf[kk] = __builtin_bit_cast(bf16x8, w); }
#pragma unroll
                for (int kk = 0; kk < 2; ++kk)
#pragma unroll
                    for (int dt = 0; dt < 8; ++dt) {
                        LAS unsigned char* ap = Vs + (32 * kk + 4 * fq + (fr >> 2)) * KP + (16 * dt + 4 * (fr & 3)) * 2;
                        const s16x4 lo = __builtin_amdgcn_ds_read_tr16_b64_v4i16((LAS s16x4*)ap), hi = __builtin_amdgcn_ds_read_tr16_b64_v4i16((LAS s16x4*)(ap + 16 * KP));
                        const bf16x8 vf = {lo[0], lo[1], lo[2], lo[3], hi[0], hi[1], hi[2], hi[3]};
                        Oacc[dt] = __builtin_amdgcn_mfma_f32_16x16x32_bf16(vf, pf[kk], Oacc[dt], 0, 0, 0);
                    }
            }
        }
        float lsum = lpart; lsum += __shfl_xor(lsum, 16); lsum += __shfl_xor(lsum, 32);
        const float inv = 1.0f / lsum;
#pragma unroll
        for (int dt = 0; dt < 8; ++dt) { const f32x4 o = Oacc[dt] * inv; u32x2 w; w.x = cvt_pk_bf16(o[0], o[1]); w.y = cvt_pk_bf16(o[2], o[3]);
            *(u32x2*)(O + (size_t)(q0 + fr) * D + h * 128 + 16 * dt + 4 * fq) = w; }
    }
    __syncthreads();
}

__device__ __forceinline__ void pool_phase(const Frame& F) {
    const bf16_t* U = (const bf16_t*)(F.ws + WS_U); bf16_t* P = (bf16_t*)(F.ws + WS_GT);
    const int col = (F.tid & 255) * 8, g = col >> 9, size = 2 << g, hs = size >> 1;
    for (int rb = F.bid; rb < SEQ / 64; rb += F.G) {
        const int t0 = rb * 64 + (F.tid >> 8) * 32;
        float s[8];
#pragma unroll
        for (int e = 0; e < 8; ++e) s[e] = 0.f;
        { int lo = t0 - hs, hi = t0 + hs - 1; lo = lo < 0 ? 0 : lo; hi = hi > SEQ ? SEQ : hi;
          for (int r = lo; r < hi; ++r) { const u32x4 v = *(const u32x4*)(U + (size_t)r * D + col);
#pragma unroll
              for (int e = 0; e < 4; ++e) { s[2 * e] += bflo(v[e]); s[2 * e + 1] += bfhi(v[e]); } } }
#pragma unroll 1
        for (int tb = t0; tb < t0 + 32; tb += 8) {
            u32x4 va[8], vs[8], vc[8];
#pragma unroll
            for (int k = 0; k < 8; ++k) { const int t = tb + k; int ra = t + hs - 1; ra = ra < SEQ ? ra : SEQ - 1; int rs = t - hs - 1; rs = rs < 0 ? 0 : rs;
                va[k] = *(const u32x4*)(U + (size_t)ra * D + col); vs[k] = *(const u32x4*)(U + (size_t)rs * D + col); vc[k] = *(const u32x4*)(U + (size_t)t * D + col); }
#pragma unroll
            for (int k = 0; k < 8; ++k) { const int t = tb + k;
                const float ma = (t + hs - 1 < SEQ) ? 1.0f : 0.0f, ms = (t - hs - 1 >= 0 && t > t0) ? 1.0f : 0.0f;
#pragma unroll
                for (int e = 0; e < 4; ++e) { s[2 * e] += ma * bflo(va[k][e]); s[2 * e + 1] += ma * bfhi(va[k][e]); }
#pragma unroll
                for (int e = 0; e < 4; ++e) { s[2 * e] -= ms * bflo(vs[k][e]); s[2 * e + 1] -= ms * bfhi(vs[k][e]); }
                int lo = t - hs, hi = t + hs; lo = lo < 0 ? 0 : lo; hi = hi > SEQ ? SEQ : hi;
                const float invn = 1.0f / (float)(hi - lo);
                u32x4 o;
#pragma unroll
                for (int e = 0; e < 4; ++e) o[e] = cvt_pk_bf16(s[2 * e] * invn - bflo(vc[k][e]), s[2 * e + 1] * invn - bfhi(vc[k][e]));
                *(u32x4*)(P + (size_t)t * D + col) = o;
            }
        }
    }
}

__global__ void __launch_bounds__(NTHR, 2) fwd_kernel(Args a_unused) {
    (void)a_unused;
    {
        Frame F = mk_frame();
        volatile LAS unsigned* MISC = (volatile LAS unsigned*)(F.lds + MISC_OFF);
        for (int u = F.tid; u < (LDS_BYTES - MISC_OFF) / 4; u += NTHR) MISC[u] = 0u;
        __syncthreads();
    }
    XcdBarrier bar;
    { Frame F = mk_frame(); bar = xcd_barrier_post((unsigned*)(F.ws + WS_CTL) + CW_BAR, (volatile LAS unsigned*)(F.lds + MISC_OFF) + 8);
      if (F.tid == 0) { const unsigned x = xb_xcc_id(); const unsigned r = xb_add((unsigned*)(F.ws + WS_CTL) + CW_XRANK + 64 * x, 1u);
          volatile LAS unsigned* M = (volatile LAS unsigned*)(F.lds + MISC_OFF); M[16] = x; M[17] = r; } }
#define GRID_BAR() xcd_barrier(bar)
    unsigned lgen = 0u;
#define LOCAL_BAR() do { volatile LAS unsigned* M_ = (volatile LAS unsigned*)((LAS unsigned char*)lds_dyn() + MISC_OFF); \
        if (M_[19] != 0u && gridDim.x == 256) xcc_local_barrier((unsigned*)(WSP + WS_CTL) + CW_LBAR + 64 * M_[16], 32u, lgen); else xcd_barrier(bar); } while (0)
    STAMP(31);

    { Frame F = mk_frame(); p0_mods(F); }
    { Frame F = mk_frame(); p0_rope(F); }
    { Frame F = mk_frame(); p0_hidden(F, F.wave, 8, 2, 3); }
    GRID_BAR(); STAMP(0);
    { Frame F = mk_frame();
      if (F.tid == 0) { volatile LAS unsigned* M = (volatile LAS unsigned*)(F.lds + MISC_OFF); bool uniform = (F.G % 8) == 0;
#if defined(FORCE_NONUNIFORM)
          uniform = false;
#endif
          for (int j = 0; j < 16; ++j) { const unsigned cnt = xb_ld((unsigned*)(F.ws + WS_CTL) + CW_XRANK + 64 * j); if (j < 8 ? cnt != (unsigned)(F.G / 8) : cnt != 0u) uniform = false; }
          M[18] = uniform ? (M[16] + 8u * M[17]) : (unsigned)F.bid; M[19] = uniform ? 1u : 0u; }
      __syncthreads(); }
    if (__builtin_amdgcn_readfirstlane(threadIdx.x >> 6) < 4) { Frame F = mk_frame(); p0_convert(F, F.wave, 4, 0); }
    else { { Frame F = mk_frame(); p0_filter_td<true>(F, F.wave - 4, 4, 1024, 1152); } { Frame F = mk_frame(); p0_hidden(F, F.wave - 4, 4, 0, 2); } }
    GRID_BAR(); STAMP(1);

    constexpr int NC = 44;
    const int nmain = (int)gridDim.x - NC;
    if ((int)blockIdx.x >= nmain) {
        unsigned sgen = 0u; unsigned* const sbar = (unsigned*)(WSP + WS_CTL) + CW_SUBBAR;
#define CTX_BAR() do { sub_barrier(sbar, (unsigned)NC, sgen); STAMP(30); } while (0)
#define CTX_FRAME() mk_frame_group(nmain, NC)
#define CTX_G1(fi) do { Frame F = CTX_FRAME(); \
        pg8::Gemm g{(const bf16_t*)(F.ws + WS_U) + (size_t)SEQ * D, (const bf16_t*)(F.ws + WS_WIN) + (size_t)(fi) * 2 * DFF * D, CTX, 2 * DFF, D, D, D, 0, 0, 0, 0}; \
        pg8::StaticOrder S; S.init(g.M, g.N, F.G, F.vcu); pg8::EpiSwiGLU E{(bf16_t*)(F.ws + WS_ACT) + (size_t)SEQ * DFFP, DFFP}; \
        pg8::gemm_phase<pg8::EpiSwiGLU>(F.lds, g, S, E); } while (0)
#define CTX_G2(fi) do { Frame F = CTX_FRAME(); \
        pg8::Gemm g{(const bf16_t*)(F.ws + WS_ACT) + (size_t)SEQ * DFFP, (const bf16_t*)(F.ws + WS_WOUT) + (size_t)(fi) * WOUT_STRIDE, 11 * 256, D, 512, DFFP, DFFP, 0, 0, 1024, 1024}; \
        pg8::StaticOrder S; S.init(g.M, g.N, F.G, F.vcu); pg8::EpiBf16 E{(bf16_t*)(F.ws + WS_P), D, nullptr, nullptr, nullptr, nullptr}; \
        pg8::gemm_phase<pg8::EpiBf16>(F.lds, g, S, E); } while (0)
        { Frame F = CTX_FRAME(); thin_phase(F, 0, true); } STAMP(27); CTX_BAR();
        CTX_G1(0); STAMP(26); CTX_BAR(); CTX_G2(0); STAMP(26); CTX_BAR();
        { Frame F = CTX_FRAME(); thin_phase(F, 1, true); } STAMP(27); CTX_BAR();
        { Frame F = CTX_FRAME();
          pg8::Gemm g{(const bf16_t*)(F.ws + WS_WHIN), (const bf16_t*)(F.ws + WS_U) + (size_t)SEQ * D, 3 * D, CTX, D, D, D, 0, 0, 0, 0};
          pg8::StaticOrder S; S.init(g.M, g.N, F.G, F.vcu); pg8::EpiBf16 E{(bf16_t*)(F.ws + WS_ZT) + SEQ, MT, nullptr, IN(I_HBIN), nullptr, nullptr};
          pg8::gemm_phase<pg8::EpiBf16>(F.lds, g, S, E); }
        STAMP(26); CTX_BAR();
        { Frame F = CTX_FRAME(); hyena_conv_ctx(F, 0); } STAMP(27); CTX_BAR();
        { Frame F = CTX_FRAME(); transpose_phase(F, SEQ, CTX); } STAMP(27); CTX_BAR();
        { Frame F = CTX_FRAME();
          pg8::Gemm g{(const bf16_t*)(F.ws + WS_U) + (size_t)SEQ * D, (const bf16_t*)(F.ws + WS_WHOUT), 4 * 256, D, 512, D, D, 0, 0, 1024, 1024};
          pg8::StaticOrder S; S.init(g.M, g.N, F.G, F.vcu); pg8::EpiBf16 E{(bf16_t*)(F.ws + WS_P), D, (const float*)(F.ws + WS_BQP) + QKVD, nullptr, nullptr, nullptr};
          pg8::gemm_phase<pg8::EpiBf16>(F.lds, g, S, E); }
        STAMP(26); CTX_BAR();
        { Frame F = CTX_FRAME(); thin_phase(F, 2, true); } STAMP(27); CTX_BAR();
        CTX_G1(1); STAMP(26); CTX_BAR(); CTX_G2(1); STAMP(26); CTX_BAR();
        { Frame F = CTX_FRAME(); thin_phase(F, 3, true); } STAMP(27); CTX_BAR();
        CTX_G1(2); STAMP(26); CTX_BAR(); CTX_G2(2); STAMP(26); CTX_BAR();
        { Frame F = CTX_FRAME(); thin_phase(F, 4, true); } STAMP(27); CTX_BAR();
        { Frame F = CTX_FRAME();
          pg8::Gemm g{(const bf16_t*)(F.ws + WS_U) + (size_t)SEQ * D, (const bf16_t*)(F.ws + WS_WQKV) + (size_t)2048 * D, CTX, 1024, D, D, D, 0, 0, 0, 0};
          pg8::StaticOrder S; S.init(g.M, g.N, F.G, F.vcu); pg8::EpiBf16 E{(bf16_t*)(F.ws + WS_KVC), 1024, (const float*)(F.ws + WS_BQP) + 2048, nullptr, nullptr, nullptr};
          pg8::gemm_phase<pg8::EpiBf16>(F.lds, g, S, E); }
    } else {
        unsigned mgen = 0u; unsigned* const mbar = (unsigned*)(WSP + WS_CTL) + CW_SUBBAR + 64;
        if (__builtin_amdgcn_readfirstlane(threadIdx.x >> 6) < 4) { Frame F = mk_frame_group(0, nmain); p0_convert(F, F.wave, 4, 1); }
        else { Frame F = mk_frame_group(0, nmain); p0_filter_td<false>(F, F.wave - 4, 4, 0, 1024); }
        sub_barrier(mbar, (unsigned)nmain, mgen); STAMP(28);
        { Frame F = mk_frame_group(0, nmain); p0_filter_fft(F); __syncthreads(); }
        STAMP(2);
        { Frame F = mk_frame_group(0, nmain); thin_phase(F, 0, false); }
    }
    GRID_BAR(); STAMP(29);

    for (int ph = 0; ph < 12; ++ph) {
        if (ph > 0) {
        { Frame F = mk_frame(); thin_phase(F, ph, false); }
        if (ph % 3 != 1) LOCAL_BAR(); else GRID_BAR();
        }
        STAMP(3);
        const int l = ph / 3, k = ph % 3, kind = l % 3, mj = l / 3;
        if (k != 1) {
            const int fi = l * 2 + (k >> 1);
            { Frame F = mk_frame();
              pg8::Gemm g{(const bf16_t*)(F.ws + WS_U), (const bf16_t*)(F.ws + WS_WIN) + (size_t)fi * 2 * DFF * D, SEQ, 2 * DFF, D, D, D, 0, 0, 0, 0};
              pg8::StaticOrder S; S.init(g.M, g.N, F.G, F.vcu);
              pg8::EpiSwiGLU E{(bf16_t*)(F.ws + WS_ACT), DFFP};
              pg8::gemm_phase<pg8::EpiSwiGLU>(F.lds, g, S, E, 22); }
            LOCAL_BAR(); STAMP(4);
        } else {
            if (kind != 2) {
                Frame F = mk_frame();
                pg8::Gemm g; pg8::EpiBf16 E;
                if (kind == 0) { g = pg8::Gemm{(const bf16_t*)(F.ws + WS_WHIN) + (size_t)mj * 3 * D * D, (const bf16_t*)(F.ws + WS_U), 3 * D, SEQ, D, D, D, 0, 0, 0, 0};
                    E = pg8::EpiBf16{(bf16_t*)(F.ws + WS_ZT), MT, nullptr, IN(I_HBIN) + (size_t)mj * 3 * D, nullptr, nullptr}; }
                else { g = pg8::Gemm{(const bf16_t*)(F.ws + WS_U), (const bf16_t*)(F.ws + WS_WQKV), SEQ, QKVD, D, D, D, 0, 0, 0, 0};
                    E = pg8::EpiBf16{(bf16_t*)(F.ws + WS_ZT), QKVD, (const float*)(F.ws + WS_BQP), nullptr, nullptr, (const f32x2*)(F.ws + WS_ROPE)}; }
                pg8::StaticOrder S; S.init(g.M, g.N, F.G, F.vcu);
                pg8::gemm_phase<pg8::EpiBf16>(F.lds, g, S, E);
            }
            if (kind != 2) { GRID_BAR(); STAMP(kind == 0 ? 6 : 10); }
            if (kind == 0) {
                { Frame F = mk_frame(); hyena_conv_phase(F, mj, mj); }
                GRID_BAR(); STAMP(7);
                { Frame F = mk_frame(); transpose_phase(F, 0, SEQ); }
                GRID_BAR(); STAMP(8);
            } else if (kind == 1) {
                { Frame F = mk_frame(); attn_phase(F); }
                GRID_BAR(); STAMP(12);
            } else {
                { Frame F = mk_frame(); pool_phase(F); }
                GRID_BAR(); STAMP(14);
            }
        }
        { Frame F = mk_frame();
          pg8::Gemm gF; pg8::EpiBf16 eF;
          if (k != 1) { const int fi = l * 2 + (k >> 1);
              gF = pg8::Gemm{(const bf16_t*)(F.ws + WS_ACT), (const bf16_t*)(F.ws + WS_WOUT) + (size_t)fi * WOUT_STRIDE, SEQ, D, DFF, DFFP, DFFP, 0, 0, 0, 0};
              eF = pg8::EpiBf16{(bf16_t*)(F.ws + WS_Y), D, nullptr, nullptr, nullptr, nullptr}; }
          else if (kind == 0) { gF = pg8::Gemm{(const bf16_t*)(F.ws + WS_U), (const bf16_t*)(F.ws + WS_WHOUT) + (size_t)mj * D * D, SEQ, D, D, D, D, 0, 0, 0, 0};
              eF = pg8::EpiBf16{(bf16_t*)(F.ws + WS_Y), D, IN(I_HBOUT) + (size_t)mj * D, nullptr, nullptr, nullptr}; }
          else if (kind == 1) { gF = pg8::Gemm{(const bf16_t*)(F.ws + WS_U), (const bf16_t*)(F.ws + WS_WO), SEQ, D, D, D, D, 0, 0, 0, 0};
              eF = pg8::EpiBf16{(bf16_t*)(F.ws + WS_Y), D, IN(I_ABO), nullptr, nullptr, nullptr}; }
          else { gF = pg8::Gemm{(const bf16_t*)(F.ws + WS_GT), (const bf16_t*)(F.ws + WS_WP), SEQ, D, 512, D, 512, 1, 512, 0, 0};
              eF = pg8::EpiBf16{(bf16_t*)(F.ws + WS_Y), D, IN(I_PB), nullptr, IN(I_PSCALE), nullptr}; }
          pg8::StaticOrder S; S.init(gF.M, gF.N, F.G, F.vcu);
          pg8::gemm_phase<pg8::EpiBf16>(F.lds, gF, S, eF, (k != 1) ? 24 : -1);
        }
        LOCAL_BAR(); STAMP(k != 1 ? 5 : (kind == 0 ? 9 : (kind == 1 ? 13 : 15)));
    }
    { Frame F = mk_frame(); thin_phase(F, 12, false); }
    STAMP(3);
#if defined(DIAG_MASK)
    if (blockIdx.x == DIAG_BLK && threadIdx.x == 0) {
        extern __shared__ __attribute__((aligned(16))) unsigned char lds_raw[];
        volatile LAS unsigned long long* ta = (volatile LAS unsigned long long*)((LAS unsigned char*)lds_raw + MISC_OFF + 256);
        unsigned long long tot = 0ull;
        for (int c = 0; c < 32; ++c) if (((unsigned long long)(DIAG_MASK) >> c) & 1ull) tot += ta[1 + c];
        OUTP[(size_t)(DIAG_BLK * 8) * D] += (float)tot * 0.0001f;
    }
#endif
}

static_assert(offsetof(Args, out) == 8 * 33 && offsetof(Args, ws) == 8 * 34 && offsetof(Args, invf) == 8 * 35 && sizeof(Args) == 8 * 67, "kernarg layout");
extern "C" void kernel_launch(void* const* d_in, const int* in_sizes, int n_in, void* d_out, int out_size, void* d_ws, size_t ws_size, hipStream_t stream) {
    static int grid = 0;
    if (grid == 0) {
        if (n_in != 33 || out_size != SEQ * D || ws_size < WS_END) { fprintf(stderr, "kernel_launch: unexpected problem: n_in %d out %d ws %zu (need %zu)\n", n_in, out_size, ws_size, (size_t)WS_END); grid = -1; return; }
        int dev = 0, cus = 0, per_cu = 0;
        if (hipGetDevice(&dev) != hipSuccess || hipDeviceGetAttribute(&cus, hipDeviceAttributeMultiprocessorCount, dev) != hipSuccess) { grid = -1; return; }
        if (hipFuncSetAttribute((const void*)fwd_kernel, hipFuncAttributeMaxDynamicSharedMemorySize, LDS_BYTES) != hipSuccess) { fprintf(stderr, "kernel_launch: hipFuncSetAttribute failed\n"); grid = -1; return; }
        if (hipOccupancyMaxActiveBlocksPerMultiprocessor(&per_cu, (const void*)fwd_kernel, NTHR, LDS_BYTES) != hipSuccess || per_cu < 1) fprintf(stderr, "kernel_launch: occupancy query says %d\n", per_cu);
        (void)hipGetLastError();
        grid = cus;
    }
    if (grid < 0) return;
    (void)in_sizes;
    if (hipMemsetAsync((char*)d_ws + WS_CTL, 0, CTL_ZERO_BYTES, stream) != hipSuccess) { fprintf(stderr, "kernel_launch: memset failed\n"); return; }
    Args a{};
    for (int i = 0; i < 33; ++i) a.in[i] = (const float*)d_in[i];
    a.out = (float*)d_out; a.ws = (unsigned char*)d_ws;
    for (int j = 0; j < 32; ++j) a.invf[j] = std::pow(10000.0, -(double)j / 32.0);
    hipLaunchKernelGGL(fwd_kernel, dim3(grid), dim3(NTHR), LDS_BYTES, stream, a);
    const hipError_t le = hipPeekAtLastError();
    if (le != hipSuccess) fprintf(stderr, "kernel_launch: launch failed: %s\n", hipGetErrorName(le));
}
```
